# Optimizing an MI355X kernel written in HIP

```python
import math
import jax, jax.numpy as jnp
from jax import lax
import numpy as np

D_MODEL = 2048
BATCH = 4
SEQ = 2048
DEPTH = 1
DEC_BATCH = 128
DEC_SEQ = 8
PAST_LEN = 8192
PAGE_SIZE = 128

D_CONV = D_MODEL // 2
CONV_WIDTH = 3
HEAD_DIM = 64
N_HEADS = (D_MODEL // 2) // HEAD_DIM
N_KV_HEADS = N_HEADS // 4
GROUP = N_HEADS // N_KV_HEADS
D_ATTN = N_HEADS * HEAD_DIM
D_KV = N_KV_HEADS * HEAD_DIM
WINDOW = 128
NUM_BUCKETS = 32
MAX_DISTANCE = 128
D_FF = -(-8 * D_MODEL // (3 * 256)) * 256
EPS = 1e-6
SPLIT_SIZES = (D_CONV, D_CONV, D_CONV, D_ATTN, D_KV, D_KV, D_MODEL, D_MODEL)
D_IN_PROJ = 3 * D_CONV + D_ATTN + 2 * D_KV + 2 * D_MODEL

kernel_name = 'hybrid_shortconv_swa_sink_decoder_step'


def rms_norm(x, g):
    xf = x.astype(jnp.float32)
    y = xf * lax.rsqrt(jnp.mean(xf * xf, axis=-1, keepdims=True) + EPS)
    return (y * g.astype(jnp.float32)).astype(x.dtype)


def t5_bucket(dist):
    dist = jnp.maximum(dist, 0)
    max_exact = NUM_BUCKETS // 2
    ratio = jnp.log(jnp.maximum(dist, 1).astype(jnp.float32) / max_exact) / math.log(MAX_DISTANCE / max_exact)
    large = max_exact + (ratio * (NUM_BUCKETS - max_exact)).astype(jnp.int32)
    large = jnp.minimum(large, NUM_BUCKETS - 1)
    return jnp.where(dist < max_exact, dist, large)


def window_attend(q, k, v, dist, valid, rel_bias, sinks):
    s = jnp.einsum('...qhgd,...shd->...hgqs', q, k).astype(jnp.float32) * (HEAD_DIM ** -0.5)
    bias = rel_bias.astype(jnp.float32)[t5_bucket(dist)]
    bias = jnp.moveaxis(bias, -1, 0).reshape(N_KV_HEADS, GROUP, dist.shape[0], dist.shape[1])
    s = jnp.where(valid, s + bias, -jnp.inf)
    sink = sinks.astype(jnp.float32).reshape(N_KV_HEADS, GROUP, 1, 1)
    m = jnp.maximum(jnp.max(s, axis=-1, keepdims=True), sink)
    p = jnp.exp(s - m)
    p = p / (jnp.sum(p, axis=-1, keepdims=True) + jnp.exp(sink - m))
    return jnp.einsum('...hgqs,...shd->...qhgd', p.astype(v.dtype), v)


def prompt_attention(q, k, v, rel_bias, sinks):
    b, t = q.shape[0], q.shape[1]
    nb = t // WINDOW
    qb = q.reshape(b, nb, WINDOW, N_KV_HEADS, GROUP, HEAD_DIM)
    kc = k.reshape(b, nb, WINDOW, N_KV_HEADS, HEAD_DIM)
    vc = v.reshape(b, nb, WINDOW, N_KV_HEADS, HEAD_DIM)
    kb = jnp.concatenate([jnp.concatenate([jnp.zeros_like(kc[:, :1]), kc[:, :-1]], axis=1), kc], axis=2)
    vb = jnp.concatenate([jnp.concatenate([jnp.zeros_like(vc[:, :1]), vc[:, :-1]], axis=1), vc], axis=2)
    qi = jnp.arange(WINDOW)[:, None]
    kj = jnp.arange(2 * WINDOW)[None, :]
    dist = qi + WINDOW - kj
    in_win = (dist >= 0) & (dist < WINDOW)
    key_pos = jnp.arange(nb)[:, None, None] * WINDOW - WINDOW + kj[None]
    valid = (in_win[None] & (key_pos >= 0))[:, None, None]
    o = window_attend(qb, kb, vb, dist, valid, rel_bias, sinks)
    return o.reshape(b, t, D_ATTN)


def sample_attention(q, k, v, k_win, v_win, rel_bias, sinks):
    b, t = q.shape[0], q.shape[1]
    wc = k_win.shape[1]
    kf = jnp.concatenate([k_win.astype(k.dtype), k], axis=1)
    vf = jnp.concatenate([v_win.astype(v.dtype), v], axis=1)
    dist = jnp.arange(t)[:, None] + wc - jnp.arange(wc + t)[None, :]
    valid = (dist >= 0) & (dist < WINDOW)
    o = window_attend(q.reshape(b, t, N_KV_HEADS, GROUP, HEAD_DIM), kf, vf, dist, valid, rel_bias, sinks)
    return o.reshape(b, t, D_ATTN), kf[:, -wc:], vf[:, -wc:]


def short_conv(u, prev, w):
    t = u.shape[1]
    full = jnp.concatenate([prev.astype(u.dtype), u], axis=1)
    out = w[0] * full[:, 0:t]
    for j in range(1, CONV_WIDTH):
        out = out + w[j] * full[:, j:j + t]
    return out, full[:, -(CONV_WIDTH - 1):]


def decoder_layer(x, conv_prev, k_win, v_win, rel_bias, w_in, w_conv, w_conv_out, sinks,
                  w_attn_out, w_o, g_mix, g_ffn, w_gate, w_up, w_down):
    b, t = x.shape[0], x.shape[1]
    xn = rms_norm(x, g_mix)
    z = xn @ w_in
    parts = []
    start = 0
    for size in SPLIT_SIZES:
        parts.append(z[..., start:start + size])
        start += size
    b_gate, c_gate, h_conv, q, k, v, gate_c, gate_a = parts
    u = c_gate * h_conv
    if conv_prev is None:
        conv_prev = jnp.zeros((b, CONV_WIDTH - 1, D_CONV), x.dtype)
    conv_out, conv_state = short_conv(u, conv_prev, w_conv)
    y_conv = (b_gate * conv_out) @ w_conv_out
    k = k.reshape(b, t, N_KV_HEADS, HEAD_DIM)
    v = v.reshape(b, t, N_KV_HEADS, HEAD_DIM)
    if k_win is None:
        attn = prompt_attention(q, k, v, rel_bias, sinks)
        wc = min(WINDOW, t)
        k_state, v_state = k[:, t - wc:], v[:, t - wc:]
    else:
        attn, k_state, v_state = sample_attention(q, k, v, k_win, v_win, rel_bias, sinks)
    y_attn = attn @ w_attn_out
    merged = jax.nn.sigmoid(gate_c) * y_conv + jax.nn.sigmoid(gate_a) * y_attn
    h = x + merged @ w_o
    hn = rms_norm(h, g_ffn)
    h = h + (jax.nn.silu(hn @ w_gate) * (hn @ w_up)) @ w_down
    return h, conv_state, k_state, v_state


def setup_inputs(seed: int = 0) -> dict:
    key = jax.random.key(seed)
    ks = jax.random.split(key, 20)
    f32 = jnp.float32
    wc = min(WINDOW, PAST_LEN)

    def nrm(k, shape, scale):
        return jax.random.normal(k, shape, f32) * scale

    return {
        'x_prompt': nrm(ks[0], (BATCH, SEQ, D_MODEL), 1.0),
        'x_sample': nrm(ks[1], (DEC_BATCH, DEC_SEQ, D_MODEL), 1.0),
        'cache_k': nrm(ks[2], (DEPTH, DEC_BATCH, wc, N_KV_HEADS, HEAD_DIM), 1.0),
        'cache_v': nrm(ks[3], (DEPTH, DEC_BATCH, wc, N_KV_HEADS, HEAD_DIM), 1.0),
        'state_conv': nrm(ks[4], (DEPTH, DEC_BATCH, CONV_WIDTH - 1, D_CONV), 1.0),
        'rel_bias': nrm(ks[5], (NUM_BUCKETS, N_HEADS), 0.5),
        'w_in': nrm(ks[6], (DEPTH, D_MODEL, D_IN_PROJ), D_MODEL ** -0.5),
        'w_conv': nrm(ks[7], (DEPTH, CONV_WIDTH, D_CONV), CONV_WIDTH ** -0.5),
        'w_conv_out': nrm(ks[8], (DEPTH, D_CONV, D_MODEL), D_CONV ** -0.5),
        'sinks': nrm(ks[9], (DEPTH, N_HEADS), 0.5),
        'w_attn_out': nrm(ks[10], (DEPTH, D_ATTN, D_MODEL), D_ATTN ** -0.5),
        'w_o': nrm(ks[11], (DEPTH, D_MODEL, D_MODEL), D_MODEL ** -0.5),
        'g_mix': 1.0 + nrm(ks[12], (DEPTH, D_MODEL), 0.02),
        'g_ffn': 1.0 + nrm(ks[13], (DEPTH, D_MODEL), 0.02),
        'w_gate': nrm(ks[14], (DEPTH, D_MODEL, D_FF), D_MODEL ** -0.5),
        'w_up': nrm(ks[15], (DEPTH, D_MODEL, D_FF), D_MODEL ** -0.5),
        'w_down': nrm(ks[16], (DEPTH, D_FF, D_MODEL), D_FF ** -0.5),
        'g_final': 1.0 + nrm(ks[17], (D_MODEL,), 0.02),
    }


def reference(x_prompt, x_sample, cache_k, cache_v, state_conv, rel_bias, w_in, w_conv, w_conv_out,
              sinks, w_attn_out, w_o, g_mix, g_ffn, w_gate, w_up, w_down, g_final):
    hp, hs = x_prompt, x_sample
    kp_l, vp_l, cp_l, ks_l, vs_l, cs_l = [], [], [], [], [], []
    for l in range(DEPTH):
        lw = (w_in[l], w_conv[l], w_conv_out[l], sinks[l], w_attn_out[l], w_o[l],
              g_mix[l], g_ffn[l], w_gate[l], w_up[l], w_down[l])
        hp, cp, kp, vp = decoder_layer(hp, None, None, None, rel_bias, *lw)
        hs, cs, ksm, vsm = decoder_layer(hs, state_conv[l], cache_k[l], cache_v[l], rel_bias, *lw)
        kp_l.append(kp); vp_l.append(vp); cp_l.append(cp)
        ks_l.append(ksm); vs_l.append(vsm); cs_l.append(cs)
    y_prompt = rms_norm(hp, g_final)
    y_sample = rms_norm(hs, g_final)
    return (y_prompt, y_sample, jnp.stack(kp_l), jnp.stack(vp_l), jnp.stack(cp_l),
            jnp.stack(ks_l), jnp.stack(vs_l), jnp.stack(cs_l))
```

```cpp
#include <hip/hip_runtime.h>
#include <cstdio>
#include <cstdint>

#ifndef MK_N_LAUNCHES
#define MK_N_LAUNCHES 1
#endif

#define LAS __attribute__((address_space(3)))
#define GAS __attribute__((address_space(1)))
typedef unsigned short bf16_t;
typedef short bf16x8 __attribute__((ext_vector_type(8)));
typedef float f32x4 __attribute__((ext_vector_type(4)));
typedef unsigned u32x4 __attribute__((ext_vector_type(4)));
typedef unsigned u32x2 __attribute__((ext_vector_type(2)));

constexpr int D = 2048, DC = 1024, DA = 1024, DKV = 256, NIN = 8704, FF = 5632, NGU = 2 * FF;
constexpr int MP = 8192, MS = 1024, M = MP + MS;
constexpr int SEQ = 2048, NBATCH = 4, DBATCH = 128, DSEQ = 8, WIN = 128;
constexpr float EPS = 1e-6f;
constexpr size_t OUT_Y = 0, OUT_KP = (size_t)M * D, OUT_VP = OUT_KP + 131072, OUT_CP = OUT_VP + 131072, OUT_KS = OUT_CP + 8192,
                 OUT_VS = OUT_KS + 4194304, OUT_CS = OUT_VS + 4194304, OUT_END = OUT_CS + 262144;
constexpr size_t MiB = 1u << 20;
constexpr size_t WS_CTL = 0, CTL_ZERO_BYTES = 1 * MiB;
constexpr size_t WS_WIN = 1 * MiB, WS_WC = 35 * MiB, WS_WA = 39 * MiB, WS_WO = 43 * MiB, WS_WGU = 51 * MiB, WS_WD = 95 * MiB;
constexpr size_t WS_XN = 117 * MiB, WS_ACONV = WS_XN, WS_ATT = WS_XN + 18 * MiB;
constexpr size_t WS_BG = 153 * MiB, WS_U = 171 * MiB, WS_Q = 189 * MiB, WS_K = 207 * MiB, WS_V = WS_K + (size_t)M * DKV * 2;
constexpr size_t WS_ACT = WS_XN;
constexpr size_t WS_SG1 = 216 * MiB, WS_SG2 = 252 * MiB;
constexpr size_t WS_END = 288 * MiB;
static_assert(WS_V + (size_t)M * DKV * 2 == 216 * MiB && WS_ACT + (size_t)M * FF * 2 == 216 * MiB, "ws map");
constexpr int CW_BAR = 4096;
constexpr int CW_ROWSS = 32768;

constexpr int RING_BYTES = 131072;
constexpr int LDSCTL_OFF = RING_BYTES, MISC_OFF = LDSCTL_OFF + 320;
constexpr int LDS_BYTES = 147456;
constexpr int NWAVES = 8;

#define LDS_WAIT() asm volatile("s_waitcnt lgkmcnt(0)" ::: "memory")
#define VM_WAIT() asm volatile("s_waitcnt vmcnt(0)" ::: "memory")
typedef float f32x2_t __attribute__((ext_vector_type(2))); typedef __bf16 bf16x2_t __attribute__((ext_vector_type(2)));
__device__ __forceinline__ unsigned cvt_pk_bf16(float lo, float hi) { const f32x2_t v = {lo, hi}; const bf16x2_t b = __builtin_convertvector(v, bf16x2_t); return __builtin_bit_cast(unsigned, b); }
__device__ __forceinline__ float bf_lo(unsigned w) { return __builtin_bit_cast(float, w << 16); }
__device__ __forceinline__ float bf_hi(unsigned w) { return __builtin_bit_cast(float, w & 0xffff0000u); }
__device__ __forceinline__ float fsigmoid(float x) { return __builtin_amdgcn_rcpf(1.0f + __expf(-x)); }
__device__ __forceinline__ float wave_sum(float v) {
#pragma unroll
    for (int o = 1; o < 64; o <<= 1) v += __shfl_xor(v, o);
    return v;
}

namespace pg8 {
constexpr int BM = 256, BK = 64, HALF = 128, HTB = HALF * BK * 2, STAGE_BYTES = 8 * HTB, NXCD = 8, WGM = 8;
__host__ __device__ __forceinline__ int lds_byte(int r, int c) { const int st = (r >> 4) * 2 + (c >> 5), rr = r & 15, cc = c & 31, ob = rr * 64 + cc * 2; return st * 1024 + (ob ^ (((ob >> 9) & 1) << 5)); }
__host__ __device__ __forceinline__ void stage_rc(int b, int& R, int& C) { const int st = b / 1024, sb = b % 1024, swz = sb ^ (((sb >> 9) & 1) << 5); R = (st >> 1) * 16 + swz / 64; C = (st & 1) * 32 + (swz % 64) / 2; }
__host__ __device__ __forceinline__ int perm32(int rho) { const int n = rho >> 4, i = rho & 15; return 8 * (i >> 2) + 4 * n + (i & 3); }

struct Unit { int pm, pn, aux; };
struct OrderMap {
    int nM, nN, nwg, G, c;
    __device__ __forceinline__ void init(int nM_, int nN_, int G_, int c_) { nM = nM_; nN = nN_; nwg = nM * nN; G = G_; c = c_; }
    __device__ __forceinline__ bool tile(int i, int& pm, int& pn) const {
        const long L = (long)i * G + c; if (L >= nwg) return false;
        int wgid = (int)L; { const int q = nwg / NXCD, r = nwg % NXCD, xcd = wgid % NXCD, off = wgid / NXCD; wgid = (xcd < r ? xcd * (q + 1) : r * (q + 1) + (xcd - r) * q) + off; }
        const int nig = WGM * nN, gid = wgid / nig, fm = gid * WGM, gsz = (nM - fm) < WGM ? (nM - fm) : WGM;
        pm = fm + ((wgid % nig) % gsz); pn = (wgid % nig) / gsz; return true;
    }
};
struct SchedG {
    OrderMap o; const char* A; const char* B; size_t tstep;
    __device__ __forceinline__ bool next(int i, Unit& u) const { u.aux = 0; return o.tile(i, u.pm, u.pn); }
    __device__ __forceinline__ const char* a_ptr(const Unit& u) const { return A + (size_t)u.pm * tstep; }
    __device__ __forceinline__ const char* b_ptr(const Unit& u) const { return B + (size_t)u.pn * tstep; }
};
struct SchedMix {
    OrderMap o; const char *A0, *A1, *B0, *B1; size_t tstep;
    __device__ __forceinline__ bool next(int i, Unit& u) const { u.aux = i & 1; return o.tile(i >> 1, u.pm, u.pn); }
    __device__ __forceinline__ const char* a_ptr(const Unit& u) const { return (u.aux ? A1 : A0) + (size_t)u.pm * tstep; }
    __device__ __forceinline__ const char* b_ptr(const Unit& u) const { return (u.aux ? B1 : B0) + (size_t)u.pn * tstep; }
};

template <class Epi, class Sched>
__device__ __forceinline__ void gemm_phase(LAS unsigned char* lds, const int K, const Sched& S, const Epi& E) {
    const int tid = threadIdx.x, wid = __builtin_amdgcn_readfirstlane(tid >> 6), lane = tid & 63, wr = wid >> 2, wc = wid & 3, fr = lane & 15, fq = lane >> 4;
    const int nt = K / BK;
    unsigned voffA[2], voffB[2];
#pragma unroll
    for (int i = 0; i < 2; ++i) { int R, C; stage_rc(tid * 16 + i * 8192, R, C); const int Rb = (R & ~31) + perm32(R & 31);
        voffA[i] = (unsigned)(R * K + C) * 2u; voffB[i] = (unsigned)(Rb * K + C) * 2u; }
    const size_t kstep = (size_t)(BK * 2);
    const size_t hstep = (size_t)HALF * K * 2;
    const unsigned ldsw = (unsigned)wid * 1024u;
    const int aoff = lds_byte(wr * 64 + fr, fq * 8), boff = lds_byte(wc * 32 + fr, fq * 8);
#define PG8_SA(b, h) (((b) * 2 + (h)) * HTB)
#define PG8_SB(b, h) ((4 + (b) * 2 + (h)) * HTB)
#define PG8_STAGE(bufoff, gbase, voff) do { _Pragma("unroll") for (int _i = 0; _i < 2; ++_i) \
        __builtin_amdgcn_global_load_lds((const unsigned*)((const char*)(gbase) + (voff)[_i]), (LAS unsigned*)(lds + (bufoff) + ldsw + _i * 8192), 16, 0, 0); } while (0)
#define PG8_LDA(dst, b, h) do { _Pragma("unroll") for (int m = 0; m < 4; ++m) _Pragma("unroll") for (int k = 0; k < 2; ++k) dst[m][k] = *(const LAS bf16x8*)(lds + PG8_SA(b, h) + aoff + m * 2048 + k * 1024); } while (0)
#define PG8_LDB(dst, b, h) do { _Pragma("unroll") for (int n = 0; n < 2; ++n) _Pragma("unroll") for (int k = 0; k < 2; ++k) dst[n][k] = *(const LAS bf16x8*)(lds + PG8_SB(b, h) + boff + n * 2048 + k * 1024); } while (0)
#define PG8_MMA(ai, bj, At, Bt) do { __builtin_amdgcn_s_setprio(1); _Pragma("unroll") for (int m = 0; m < 4; ++m) _Pragma("unroll") for (int n = 0; n < 2; ++n) _Pragma("unroll") for (int k = 0; k < 2; ++k) \
        acc[ai][bj][m][n] = __builtin_amdgcn_mfma_f32_16x16x32_bf16(Bt[n][k], At[m][k], acc[ai][bj][m][n], 0, 0, 0); __builtin_amdgcn_s_setprio(0); } while (0)
#define PG8_WAIT_V(n) asm volatile("s_waitcnt vmcnt(" #n ")" ::: "memory")
#define PG8_WAIT_L(n) asm volatile("s_waitcnt lgkmcnt(" #n ")" ::: "memory")
#define PG8_BAR __builtin_amdgcn_s_barrier()
#define PG8_SCHED __builtin_amdgcn_sched_barrier(0)
    Unit cur, nxt; int ui = 0;
    if (!S.next(0, cur)) return;
    f32x4 acc[2][2][4][2];
#pragma unroll
    for (int a = 0; a < 2; ++a)
#pragma unroll
        for (int b = 0; b < 2; ++b)
#pragma unroll
            for (int m = 0; m < 4; ++m)
#pragma unroll
                for (int n = 0; n < 2; ++n) acc[a][b][m][n] = (f32x4){0.f, 0.f, 0.f, 0.f};
    bf16x8 At[4][2], B0[2][2], B1[2][2];
    const char* cA = S.a_ptr(cur); const char* cB = S.b_ptr(cur);
    PG8_STAGE(PG8_SB(0, 0), cB, voffB); PG8_STAGE(PG8_SB(0, 1), cB + hstep, voffB); PG8_STAGE(PG8_SA(0, 0), cA, voffA); PG8_STAGE(PG8_SA(0, 1), cA + hstep, voffA);
    if (wr == 1) PG8_BAR;
    PG8_WAIT_V(2); PG8_BAR;
    PG8_STAGE(PG8_SB(1, 0), cB + kstep, voffB); PG8_STAGE(PG8_SA(1, 0), cA + kstep, voffA); PG8_STAGE(PG8_SB(1, 1), cB + hstep + kstep, voffB);
    PG8_WAIT_V(6); PG8_BAR;
    for (;;) {
        const bool has_next = S.next(ui + 1, nxt);
        const char* nA = has_next ? S.a_ptr(nxt) : cA; const char* nB = has_next ? S.b_ptr(nxt) : cB;
        for (int t = 0; t < nt; t += 2) {
            const bool last = (t == nt - 2);
            const char* a1 = cA + (size_t)(t + 1) * kstep;
            const char* a2 = last ? nA : cA + (size_t)(t + 2) * kstep; const char* b2 = last ? nB : cB + (size_t)(t + 2) * kstep;
            const char* a3 = a2 + kstep; const char* b3 = b2 + kstep;
            PG8_LDB(B0, 0, 0); PG8_LDB(B1, 0, 1); PG8_SCHED; PG8_LDA(At, 0, 0); PG8_STAGE(PG8_SA(1, 1), a1 + hstep, voffA);
            PG8_WAIT_V(8); PG8_WAIT_L(0); PG8_BAR; PG8_MMA(0, 0, At, B0); PG8_MMA(0, 1, At, B1); PG8_BAR; PG8_SCHED;
            PG8_LDA(At, 0, 1); PG8_STAGE(PG8_SB(0, 0), b2, voffB); PG8_STAGE(PG8_SB(0, 1), b2 + hstep, voffB); PG8_STAGE(PG8_SA(0, 0), a2, voffA);
            PG8_WAIT_V(8); PG8_WAIT_L(0); PG8_BAR; PG8_MMA(1, 0, At, B0); PG8_MMA(1, 1, At, B1); PG8_BAR; PG8_SCHED;
            PG8_LDB(B0, 1, 0); PG8_LDB(B1, 1, 1); PG8_SCHED; PG8_LDA(At, 1, 0); PG8_STAGE(PG8_SA(0, 1), a2 + hstep, voffA);
            PG8_WAIT_V(8); PG8_WAIT_L(0); PG8_BAR; PG8_MMA(0, 0, At, B0); PG8_MMA(0, 1, At, B1); PG8_BAR; PG8_SCHED;
            PG8_LDA(At, 1, 1); PG8_STAGE(PG8_SB(1, 0), b3, voffB); PG8_STAGE(PG8_SB(1, 1), b3 + hstep, voffB); PG8_STAGE(PG8_SA(1, 0), a3, voffA);
            PG8_WAIT_V(8); PG8_WAIT_L(0); PG8_BAR; PG8_MMA(1, 0, At, B0); PG8_MMA(1, 1, At, B1); PG8_BAR; PG8_SCHED;
        }
        if (wr == 0) PG8_BAR;
        E(acc, cur, wr, wc, fr, fq);
        if (!has_next) break;
        if (!E.keep(cur)) {
#pragma unroll
            for (int a = 0; a < 2; ++a)
#pragma unroll
                for (int b = 0; b < 2; ++b)
#pragma unroll
                    for (int m = 0; m < 4; ++m)
#pragma unroll
                        for (int n = 0; n < 2; ++n) acc[a][b][m][n] = (f32x4){0.f, 0.f, 0.f, 0.f};
        }
        cur = nxt; cA = nA; cB = nB; ++ui;
        if (wr == 1) PG8_BAR;
    }
    PG8_WAIT_V(0);
    PG8_BAR;
#undef PG8_SA
#undef PG8_SB
#undef PG8_STAGE
#undef PG8_LDA
#undef PG8_LDB
#undef PG8_MMA
#undef PG8_WAIT_V
#undef PG8_WAIT_L
#undef PG8_BAR
#undef PG8_SCHED
}

__device__ __forceinline__ u32x4 pack8(const f32x4 v0, const f32x4 v1) { u32x4 w; w.x = cvt_pk_bf16(v0[0], v0[1]); w.y = cvt_pk_bf16(v0[2], v0[3]); w.z = cvt_pk_bf16(v1[0], v1[1]); w.w = cvt_pk_bf16(v1[2], v1[3]); return w; }
__device__ __forceinline__ void unpack8(const u32x4 w, f32x4& v0, f32x4& v1) { v0 = (f32x4){bf_lo(w.x), bf_hi(w.x), bf_lo(w.y), bf_hi(w.y)}; v1 = (f32x4){bf_lo(w.z), bf_hi(w.z), bf_lo(w.w), bf_hi(w.w)}; }

struct EpiIn {
    bf16_t *Bg, *U, *Q, *Kb, *Vb, *SG1, *SG2; float* out;
    __device__ __forceinline__ bool keep(const Unit&) const { return false; }
    __device__ __forceinline__ void operator()(f32x4 (&acc)[2][2][4][2], const Unit& u, int wr, int wc, int fr, int fq) const {
        const int pn = u.pn, row0 = u.pm * BM + wr * 64 + fr, cl = wc * 32 + 8 * fq;
        if (pn >= 4 && pn < 12) {
            const int ch = 128 * (pn - 4) + cl;
#pragma unroll
            for (int ai = 0; ai < 2; ++ai)
#pragma unroll
                for (int m = 0; m < 4; ++m) {
                    const int row = row0 + ai * HALF + m * 16;
                    const f32x4 u0 = acc[ai][0][m][0] * acc[ai][1][m][0], u1 = acc[ai][0][m][1] * acc[ai][1][m][1];
                    *(u32x4*)(U + (size_t)row * DC + ch) = pack8(u0, u1);
                    bool st; size_t idx;
                    if (row < MP) { const int t = row & (SEQ - 1); st = t >= SEQ - 2; idx = OUT_CP + (size_t)((row >> 11) * 2 + (t - (SEQ - 2))) * DC + ch; }
                    else { const int s = row - MP, t = s & 7; st = t >= 6; idx = OUT_CS + (size_t)((s >> 3) * 2 + (t - 6)) * DC + ch; }
                    if (st) { *(f32x4*)(out + idx) = u0; *(f32x4*)(out + idx + 4) = u1; }
                }
            return;
        }
        bf16_t* dst; int ld, col0; float sc = 1.f; bool sig = false; int side = 0;
        if (pn < 4) { dst = Bg; ld = DC; col0 = 256 * pn; }
        else if (pn < 16) { dst = Q; ld = DA; col0 = 256 * (pn - 12); sc = 0.125f; }
        else if (pn == 16) { dst = Kb; ld = DKV; col0 = 0; side = 1; }
        else if (pn == 17) { dst = Vb; ld = DKV; col0 = 0; side = 2; }
        else if (pn < 26) { dst = SG1; ld = D; col0 = 256 * (pn - 18); sig = true; }
        else { dst = SG2; ld = D; col0 = 256 * (pn - 26); sig = true; }
#pragma unroll
        for (int ai = 0; ai < 2; ++ai)
#pragma unroll
            for (int m = 0; m < 4; ++m) {
                const int row = row0 + ai * HALF + m * 16;
                bool st = false; size_t sidx = 0;
                if (side) {
                    if (row < MP) { const int t = row & (SEQ - 1); st = t >= SEQ - WIN; sidx = (side == 1 ? OUT_KP : OUT_VP) + (size_t)((row >> 11) * WIN + (t - (SEQ - WIN))) * DKV; }
                    else { const int s = row - MP; st = true; sidx = (side == 1 ? OUT_KS : OUT_VS) + (size_t)((s >> 3) * WIN + (WIN - DSEQ) + (s & 7)) * DKV; }
                }
#pragma unroll
                for (int bj = 0; bj < 2; ++bj) {
                    f32x4 v0 = acc[ai][bj][m][0], v1 = acc[ai][bj][m][1];
                    if (st) { *(f32x4*)(out + sidx + bj * HALF + cl) = v0; *(f32x4*)(out + sidx + bj * HALF + cl + 4) = v1; }
                    if (sig) {
#pragma unroll
                        for (int j = 0; j < 4; ++j) { v0[j] = fsigmoid(v0[j]); v1[j] = fsigmoid(v1[j]); }
                    } else { v0 = v0 * sc; v1 = v1 * sc; }
                    *(u32x4*)(dst + (size_t)row * ld + col0 + bj * HALF + cl) = pack8(v0, v1);
                }
            }
    }
};
struct EpiMix {
    bf16_t *SG1, *SG2;
    __device__ __forceinline__ bool keep(const Unit& u) const { return u.aux == 0; }
    __device__ __forceinline__ void operator()(f32x4 (&acc)[2][2][4][2], const Unit& u, int wr, int wc, int fr, int fq) const {
        const int row0 = u.pm * BM + wr * 64 + fr, col0 = u.pn * BM + wc * 32 + 8 * fq;
#pragma unroll
        for (int ai = 0; ai < 2; ++ai)
#pragma unroll
            for (int m = 0; m < 4; ++m) {
                const size_t off = (size_t)(row0 + ai * HALF + m * 16) * D + col0;
#pragma unroll
                for (int bj = 0; bj < 2; ++bj) {
                    f32x4 a0, a1; unpack8(*(const u32x4*)(SG2 + off + bj * HALF), a0, a1);
                    if (u.aux == 0) {
                        f32x4 c0, c1; unpack8(*(const u32x4*)(SG1 + off + bj * HALF), c0, c1);
#pragma unroll
                        for (int j = 0; j < 4; ++j) { acc[ai][bj][m][0][j] *= c0[j] * __builtin_amdgcn_rcpf(fmaxf(a0[j], 1e-30f)); acc[ai][bj][m][1][j] *= c1[j] * __builtin_amdgcn_rcpf(fmaxf(a1[j], 1e-30f)); }
                    } else {
                        *(u32x4*)(SG1 + off + bj * HALF) = pack8(acc[ai][bj][m][0] * a0, acc[ai][bj][m][1] * a1);
                    }
                }
            }
    }
};
struct EpiWo {
    const float *xp, *xs; float* H; bf16_t* HB; float* rowss;
    __device__ __forceinline__ bool keep(const Unit&) const { return false; }
    __device__ __forceinline__ void operator()(f32x4 (&acc)[2][2][4][2], const Unit& u, int wr, int wc, int fr, int fq) const {
        const int row0 = u.pm * BM + wr * 64 + fr, col0 = u.pn * BM + wc * 32 + 8 * fq;
        const float* xb = (u.pm < MP / BM) ? xp : xs - (size_t)MP * D;
#pragma unroll
        for (int ai = 0; ai < 2; ++ai)
#pragma unroll
            for (int m = 0; m < 4; ++m) {
                const int row = row0 + ai * HALF + m * 16; const size_t off = (size_t)row * D + col0; float ss = 0.f;
#pragma unroll
                for (int bj = 0; bj < 2; ++bj) {
                    const f32x4 h0 = *(const f32x4*)(xb + off + bj * HALF) + acc[ai][bj][m][0], h1 = *(const f32x4*)(xb + off + bj * HALF + 4) + acc[ai][bj][m][1];
                    *(f32x4*)(H + off + bj * HALF) = h0; *(f32x4*)(H + off + bj * HALF + 4) = h1;
                    *(u32x4*)(HB + off + bj * HALF) = pack8(h0, h1);
                    ss += (h0[0] * h0[0] + h0[1] * h0[1]) + (h0[2] * h0[2] + h0[3] * h0[3]) + (h1[0] * h1[0] + h1[1] * h1[1]) + (h1[2] * h1[2] + h1[3] * h1[3]);
                }
                ss += __shfl_xor(ss, 16); ss += __shfl_xor(ss, 32);
                if (fq == 0) __hip_atomic_fetch_add(rowss + row, ss, __ATOMIC_RELAXED, __HIP_MEMORY_SCOPE_AGENT);
            }
    }
};
struct EpiGU {
    bf16_t* ACT; const float* rowss;
    __device__ __forceinline__ bool keep(const Unit&) const { return false; }
    __device__ __forceinline__ void operator()(f32x4 (&acc)[2][2][4][2], const Unit& u, int wr, int wc, int fr, int fq) const {
        const int row0 = u.pm * BM + wr * 64 + fr, ch = 128 * u.pn + wc * 32 + 8 * fq;
#pragma unroll
        for (int ai = 0; ai < 2; ++ai)
#pragma unroll
            for (int m = 0; m < 4; ++m) {
                const int row = row0 + ai * HALF + m * 16;
                const float rstd = __builtin_amdgcn_rsqf(__hip_atomic_load(rowss + row, __ATOMIC_RELAXED, __HIP_MEMORY_SCOPE_AGENT) * (1.0f / D) + EPS);
                f32x4 o[2];
#pragma unroll
                for (int n = 0; n < 2; ++n)
#pragma unroll
                    for (int j = 0; j < 4; ++j) { const float g = acc[ai][0][m][n][j] * rstd, up = acc[ai][1][m][n][j] * rstd; o[n][j] = g * fsigmoid(g) * up; }
                *(u32x4*)(ACT + (size_t)row * FF + ch) = pack8(o[0], o[1]);
            }
    }
};
struct EpiDown {
    float* H;
    __device__ __forceinline__ bool keep(const Unit&) const { return false; }
    __device__ __forceinline__ void operator()(f32x4 (&acc)[2][2][4][2], const Unit& u, int wr, int wc, int fr, int fq) const {
        const int row0 = u.pm * BM + wr * 64 + fr, col0 = u.pn * BM + wc * 32 + 8 * fq;
#pragma unroll
        for (int ai = 0; ai < 2; ++ai)
#pragma unroll
            for (int m = 0; m < 4; ++m) {
                float* p = H + (size_t)(row0 + ai * HALF + m * 16) * D + col0;
#pragma unroll
                for (int bj = 0; bj < 2; ++bj) {
                    const f32x4 h0 = *(const f32x4*)(p + bj * HALF) + acc[ai][bj][m][0], h1 = *(const f32x4*)(p + bj * HALF + 4) + acc[ai][bj][m][1];
                    *(f32x4*)(p + bj * HALF) = h0; *(f32x4*)(p + bj * HALF + 4) = h1;
                }
            }
    }
};
}

#define XB_TMO      128
#define XB_XCNT(j)  (256  + 64 * (j))
#define XB_XSUB(j)  (1280 + 64 * (j))
#define XB_XGEN(j)  (2304 + 64 * (j))
#define XB_TOP      3328
#define XB_TOPGEN   3392
#define XCD_BAR_WORDS 3456
#define XB_SPIN_CAP (1u << 18)
__device__ __forceinline__ unsigned xb_ld(unsigned* p)              { return __hip_atomic_load(p, __ATOMIC_RELAXED, __HIP_MEMORY_SCOPE_AGENT); }
__device__ __forceinline__ unsigned xb_add(unsigned* p, unsigned v) { return __hip_atomic_fetch_add(p, v, __ATOMIC_RELAXED, __HIP_MEMORY_SCOPE_AGENT); }
__device__ __forceinline__ unsigned xb_xcc_id() { return (unsigned)__builtin_amdgcn_s_getreg((3 << 11) | 20) & 0xFu; }
#define XB_SPIN(cond, bar) do { unsigned _sp = 0; while (cond) { __builtin_amdgcn_s_sleep(1); \
    if ((++_sp & 255u) == 0u) { if (xb_ld(&(bar)[XB_TMO])) break; if (_sp > XB_SPIN_CAP) { atomicAdd(&(bar)[XB_TMO], 1u); break; } } } } while (0)
struct XcdBarrier { unsigned* bar; unsigned x; volatile LAS unsigned* st; };
__device__ __forceinline__ XcdBarrier xcd_barrier_post(unsigned* bar, volatile LAS unsigned* st) {
    XcdBarrier b; b.bar = bar; b.x = xb_xcc_id(); b.st = st;
    if (threadIdx.x == 0) (void)xb_add(&bar[XB_XCNT(b.x)], 1u);
    return b;
}
__device__ __forceinline__ void xcd_barrier_complete(unsigned* bar, unsigned x, unsigned& nloc, unsigned& nx) {
    const unsigned G = gridDim.x * gridDim.y * gridDim.z;
    unsigned sum, cnt, mine, sp = 0u;
    for (;;) {
        sum = 0u; cnt = 0u; mine = 0u;
#pragma unroll
        for (unsigned j = 0; j < 16; ++j) { const unsigned c = xb_ld(&bar[XB_XCNT(j)]); sum += c; cnt += (c > 0u) ? 1u : 0u; mine = (j == x) ? c : mine; }
        if (sum == G) break;
        __builtin_amdgcn_s_sleep(1);
        if ((++sp & 255u) == 0u) { if (xb_ld(&bar[XB_TMO])) break; if (sp > XB_SPIN_CAP) { atomicAdd(&bar[XB_TMO], 1u); break; } }
    }
    nloc = mine > 0u ? mine : 1u; nx = cnt > 0u ? cnt : 1u;
}
__device__ __forceinline__ void xcd_barrier(const XcdBarrier& b) {
    asm volatile("s_waitcnt vmcnt(0)" ::: "memory");
    __syncthreads();
    if (threadIdx.x == 0) {
        unsigned* bar = b.bar;
        __builtin_amdgcn_s_waitcnt(0);
        unsigned nloc = b.st[0], nx = b.st[1];
        if (nloc == 0u) { xcd_barrier_complete(bar, b.x, nloc, nx); b.st[0] = nloc; b.st[1] = nx; }
        const unsigned old = xb_add(&bar[XB_XSUB(b.x)], 1u);
        const unsigned gen = old / nloc;
        if (old + 1u == (gen + 1u) * nloc) {
            __builtin_amdgcn_fence(__ATOMIC_RELEASE, "agent");
            asm volatile("s_waitcnt vmcnt(0)" ::: "memory");
            const unsigned og = xb_add(&bar[XB_TOP], 1u);
            const unsigned tg = og / nx;
            if (og + 1u == (tg + 1u) * nx) xb_add(&bar[XB_TOPGEN], 1u);
            else XB_SPIN(xb_ld(&bar[XB_TOPGEN]) == tg, bar);
            __builtin_amdgcn_fence(__ATOMIC_ACQUIRE, "agent");
            xb_add(&bar[XB_XGEN(b.x)], 1u);
            asm volatile("s_waitcnt vmcnt(0)" ::: "memory");
        } else {
            XB_SPIN(xb_ld(&bar[XB_XGEN(b.x)]) == gen, bar);
            __builtin_amdgcn_fence(__ATOMIC_ACQUIRE, "agent");
            asm volatile("s_waitcnt vmcnt(0)" ::: "memory");
        }
    }
    __syncthreads();
}

struct Args {
    const float *x_prompt, *x_sample, *cache_k, *cache_v, *state_conv, *rel_bias, *w_in, *w_conv, *w_conv_out, *sinks, *w_attn_out, *w_o, *g_mix, *g_ffn, *w_gate, *w_up, *w_down, *g_final;
    float* out; unsigned char* ws; int ph_lo, ph_hi;
};
struct Frame { LAS unsigned char* lds; int tid, lane, wave, vcu, G; };

static __device__ const unsigned char T5_BUCKET[128] = {
    0, 1, 2, 3, 4, 5, 6, 7, 8, 9, 10, 11, 12, 13, 14, 15, 16, 16, 16, 17, 17, 18, 18, 18, 19, 19, 19, 20, 20, 20, 20, 21, 21, 21, 21, 22, 22, 22, 22, 22, 23, 23, 23, 23, 23, 23,
    24, 24, 24, 24, 24, 24, 25, 25, 25, 25, 25, 25, 25, 26, 26, 26, 26, 26, 26, 26, 26, 27, 27, 27, 27, 27, 27, 27, 27, 27, 27, 28, 28, 28, 28, 28, 28, 28, 28, 28, 28,
    29, 29, 29, 29, 29, 29, 29, 29, 29, 29, 29, 29, 30, 30, 30, 30, 30, 30, 30, 30, 30, 30, 30, 30, 30, 30, 31, 31, 31, 31, 31, 31, 31, 31, 31, 31, 31, 31, 31, 31, 31};

__device__ __forceinline__ void p0_transpose_item(const float* W, int K, int N, bf16_t* WT, int k0, int n0, int dst_row0, const float* gk, LAS float* scr, int lane) {
#pragma unroll 8
    for (int i = 0; i < 32; ++i) { const int kk = 2 * i + (lane >> 5); scr[kk * 33 + (lane & 31)] = W[(size_t)(k0 + kk) * N + n0 + (lane & 31)]; }
    const int c = lane & 7;
    float gs[8];
#pragma unroll
    for (int e = 0; e < 8; ++e) gs[e] = gk ? gk[k0 + 8 * c + e] : 1.0f;
    LDS_WAIT(); asm volatile("" ::: "memory");
#pragma unroll
    for (int j = 0; j < 4; ++j) { const int n = (lane >> 3) + 8 * j; const LAS float* s = scr + (8 * c) * 33 + n;
        u32x4 o; o.x = cvt_pk_bf16(s[0 * 33] * gs[0], s[1 * 33] * gs[1]); o.y = cvt_pk_bf16(s[2 * 33] * gs[2], s[3 * 33] * gs[3]); o.z = cvt_pk_bf16(s[4 * 33] * gs[4], s[5 * 33] * gs[5]); o.w = cvt_pk_bf16(s[6 * 33] * gs[6], s[7 * 33] * gs[7]);
        *(u32x4*)(WT + (size_t)(dst_row0 + n) * K + k0 + 8 * c) = o; }
    LDS_WAIT(); asm volatile("" ::: "memory");
}
__device__ __forceinline__ void p0_prologue(const Frame& F, const Args& a) {
    unsigned char* ws = a.ws;
    LAS float* scr = (LAS float*)(F.lds + F.wave * 16384);
    const int gw = F.vcu * NWAVES + F.wave, NGW = F.G * NWAVES;
    constexpr int I_IN = (D / 64) * (NIN / 32), I_C = (DC / 64) * (D / 32), I_A = I_C, I_O = (D / 64) * (D / 32), I_G = (D / 64) * (FF / 32), I_U = I_G, I_D = (FF / 64) * (D / 32);
    constexpr int NITEMS = I_IN + I_C + I_A + I_O + I_G + I_U + I_D;
    for (int it = gw; it < NITEMS; it += NGW) {
        int r = it;
        if (r < I_IN) { const int nblk = NIN / 32, kb = r / nblk, nb = r % nblk, n0 = 32 * nb; int dr;
            if (n0 < 1024) dr = n0;
            else if (n0 < 2048) { const int c0 = n0 - 1024; dr = 1024 + 256 * (c0 >> 7) + (c0 & 127); }
            else if (n0 < 3072) { const int c0 = n0 - 2048; dr = 1024 + 256 * (c0 >> 7) + 128 + (c0 & 127); }
            else dr = n0;
            p0_transpose_item(a.w_in, D, NIN, (bf16_t*)(ws + WS_WIN), 64 * kb, n0, dr, nullptr, scr, F.lane); continue; } r -= I_IN;
        if (r < I_C) { const int nblk = D / 32, kb = r / nblk, nb = r % nblk; p0_transpose_item(a.w_conv_out, DC, D, (bf16_t*)(ws + WS_WC), 64 * kb, 32 * nb, 32 * nb, nullptr, scr, F.lane); continue; } r -= I_C;
        if (r < I_A) { const int nblk = D / 32, kb = r / nblk, nb = r % nblk; p0_transpose_item(a.w_attn_out, DA, D, (bf16_t*)(ws + WS_WA), 64 * kb, 32 * nb, 32 * nb, nullptr, scr, F.lane); continue; } r -= I_A;
        if (r < I_O) { const int nblk = D / 32, kb = r / nblk, nb = r % nblk; p0_transpose_item(a.w_o, D, D, (bf16_t*)(ws + WS_WO), 64 * kb, 32 * nb, 32 * nb, nullptr, scr, F.lane); continue; } r -= I_O;
        if (r < I_G) { const int nblk = FF / 32, kb = r / nblk, nb = r % nblk, n0 = 32 * nb; p0_transpose_item(a.w_gate, D, FF, (bf16_t*)(ws + WS_WGU), 64 * kb, n0, 256 * (n0 >> 7) + (n0 & 127), a.g_ffn, scr, F.lane); continue; } r -= I_G;
        if (r < I_U) { const int nblk = FF / 32, kb = r / nblk, nb = r % nblk, n0 = 32 * nb; p0_transpose_item(a.w_up, D, FF, (bf16_t*)(ws + WS_WGU), 64 * kb, n0, 256 * (n0 >> 7) + 128 + (n0 & 127), a.g_ffn, scr, F.lane); continue; } r -= I_U;
        { const int nblk = D / 32, kb = r / nblk, nb = r % nblk; p0_transpose_item(a.w_down, FF, D, (bf16_t*)(ws + WS_WD), 64 * kb, 32 * nb, 32 * nb, nullptr, scr, F.lane); }
    }
    bf16_t* XN = (bf16_t*)(ws + WS_XN);
    for (int m = gw; m < M; m += NGW) {
        const float* xrow = (m < MP) ? a.x_prompt + (size_t)m * D : a.x_sample + (size_t)(m - MP) * D;
        const f32x4* xr = (const f32x4*)xrow + F.lane; const f32x4* gr = (const f32x4*)a.g_mix + F.lane;
        f32x4 v[8]; float s = 0.f;
#pragma unroll
        for (int j = 0; j < 8; ++j) { v[j] = xr[64 * j]; s += (v[j][0] * v[j][0] + v[j][1] * v[j][1]) + (v[j][2] * v[j][2] + v[j][3] * v[j][3]); }
        const float rstd = __builtin_amdgcn_rsqf(wave_sum(s) * (1.0f / D) + EPS);
        u32x2* o8 = (u32x2*)(XN + (size_t)m * D) + F.lane;
#pragma unroll
        for (int j = 0; j < 8; ++j) { const f32x4 g = gr[64 * j]; u32x2 w; w.x = cvt_pk_bf16(v[j][0] * rstd * g[0], v[j][1] * rstd * g[1]); w.y = cvt_pk_bf16(v[j][2] * rstd * g[2], v[j][3] * rstd * g[3]); o8[64 * j] = w; }
    }
    { float* rs = (float*)((unsigned*)(ws + WS_CTL) + CW_ROWSS); for (int i = F.vcu * (NWAVES * 64) + F.tid; i < M; i += F.G * (NWAVES * 64)) rs[i] = 0.f; }
    {
        const size_t per_b = (size_t)(WIN - DSEQ) * DKV / 4, total = (size_t)DBATCH * per_b;
        for (size_t i = (size_t)F.vcu * (NWAVES * 64) + F.tid; i < 2 * total; i += (size_t)F.G * (NWAVES * 64)) {
            const int which = i >= total; const size_t j = which ? i - total : i; const size_t b = j / per_b, r = j % per_b;
            const f32x4* src = (const f32x4*)(which ? a.cache_v : a.cache_k) + b * ((size_t)WIN * DKV / 4) + (size_t)DSEQ * DKV / 4 + r;
            f32x4* dst = (f32x4*)(a.out + (which ? OUT_VS : OUT_KS)) + b * ((size_t)WIN * DKV / 4) + r;
            *dst = *src;
        }
    }
}

constexpr int KIMG_STRIDE = 144, VT_STRIDE = 528;
constexpr int LDS_KIMG = 0, LDS_VT = 256 * KIMG_STRIDE, LDS_LUT = LDS_VT + 64 * VT_STRIDE, LDS_SINK = LDS_LUT + 4 * 128 * 4;
static_assert(LDS_SINK + 16 <= RING_BYTES, "attention LDS");

__device__ __forceinline__ void attn_group(LAS const unsigned char* lds, const int key0, const bf16x8 q0, const bf16x8 q1, const int dist0, const int min_krow, const int hl, bf16_t* outp, const int lane) {
    const int l15 = lane & 15, g = lane >> 4;
    f32x4 s[10];
    LAS const unsigned char* kp = lds + LDS_KIMG + (key0 + l15) * KIMG_STRIDE + g * 16;
#pragma unroll
    for (int T = 0; T < 10; ++T) {
        const bf16x8 k0f = *(LAS const bf16x8*)(kp + T * 16 * KIMG_STRIDE), k1f = *(LAS const bf16x8*)(kp + T * 16 * KIMG_STRIDE + 64);
        f32x4 a = (f32x4){0.f, 0.f, 0.f, 0.f};
        a = __builtin_amdgcn_mfma_f32_16x16x32_bf16(k0f, q0, a, 0, 0, 0);
        a = __builtin_amdgcn_mfma_f32_16x16x32_bf16(k1f, q1, a, 0, 0, 0);
        s[T] = a;
    }
    LAS const float* lut = (LAS const float*)(lds + LDS_LUT) + hl * 128;
    float mx = -INFINITY;
#pragma unroll
    for (int T = 0; T < 10; ++T)
#pragma unroll
        for (int r = 0; r < 4; ++r) {
            const int kk = 16 * T + 4 * g + r, dist = dist0 - kk;
            const bool valid = ((unsigned)dist < 128u) && (key0 + kk >= min_krow);
            const float v = valid ? s[T][r] + lut[dist & 127] : -INFINITY;
            s[T][r] = v; mx = fmaxf(mx, v);
        }
    mx = fmaxf(mx, __shfl_xor(mx, 16)); mx = fmaxf(mx, __shfl_xor(mx, 32));
    const float sink = ((LAS const float*)(lds + LDS_SINK))[hl];
    mx = fmaxf(mx, sink);
    float sum = 0.f;
#pragma unroll
    for (int T = 0; T < 10; ++T)
#pragma unroll
        for (int r = 0; r < 4; ++r) { const float p = __expf(s[T][r] - mx); s[T][r] = p; sum += p; }
    sum += __shfl_xor(sum, 16); sum += __shfl_xor(sum, 32);
    sum += __expf(sink - mx);
    const float inv = 1.0f / sum;
    bf16x8 pf[5];
#pragma unroll
    for (int P = 0; P < 5; ++P) pf[P] = __builtin_bit_cast(bf16x8, pg8::pack8(s[2 * P] * inv, s[2 * P + 1] * inv));
#pragma unroll
    for (int dt = 0; dt < 4; ++dt) {
        f32x4 o = (f32x4){0.f, 0.f, 0.f, 0.f};
        LAS const unsigned char* vp = lds + LDS_VT + (16 * dt + l15) * VT_STRIDE + (key0 + 4 * g) * 2;
#pragma unroll
        for (int P = 0; P < 5; ++P) {
            const u32x2 lo = *(LAS const u32x2*)(vp + 64 * P), hi = *(LAS const u32x2*)(vp + 64 * P + 32);
            const bf16x8 vf = __builtin_bit_cast(bf16x8, (u32x4){lo.x, lo.y, hi.x, hi.y});
            o = __builtin_amdgcn_mfma_f32_16x16x32_bf16(vf, pf[P], o, 0, 0, 0);
        }
        u32x2 w; w.x = cvt_pk_bf16(o[0], o[1]); w.y = cvt_pk_bf16(o[2], o[3]);
        *(u32x2*)(outp + 16 * dt + 4 * g) = w;
    }
}

__device__ __forceinline__ void p2_attention_conv(const Frame& F, const Args& a) {
    unsigned char* ws = a.ws;
    const bf16_t* Qb = (const bf16_t*)(ws + WS_Q); const bf16_t* Kb = (const bf16_t*)(ws + WS_K); const bf16_t* Vb = (const bf16_t*)(ws + WS_V);
    bf16_t* ATT = (bf16_t*)(ws + WS_ATT);
    LAS unsigned char* lds = F.lds;
    const int tid = F.tid, lane = F.lane, wave = F.wave, l15 = lane & 15, g = lane >> 4;
    for (int u = blockIdx.x; u < NBATCH * 16 * 4; u += F.G) {
        const int b = u >> 6, nb = (u >> 2) & 15, kvh = u & 3;
        __syncthreads();
        {
            const int hl = tid >> 7, dist = tid & 127;
            ((LAS float*)(lds + LDS_LUT))[tid] = a.rel_bias[T5_BUCKET[dist] * 16 + kvh * 4 + hl];
            if (tid < 4) ((LAS float*)(lds + LDS_SINK))[tid] = a.sinks[kvh * 4 + tid];
        }
#pragma unroll
        for (int i = 0; i < 4; ++i) {
            const int id = tid + 512 * i, r = id >> 3, c8 = id & 7, t = nb * WIN - WIN + r;
            u32x4 kv = (u32x4){0u, 0u, 0u, 0u}, vv = (u32x4){0u, 0u, 0u, 0u};
            if (t >= 0) { const size_t off = (size_t)(b * SEQ + t) * DKV + kvh * 64 + c8 * 8; kv = *(const u32x4*)(Kb + off); vv = *(const u32x4*)(Vb + off); }
            *(LAS u32x4*)(lds + LDS_KIMG + r * KIMG_STRIDE + c8 * 16) = kv;
            LAS unsigned char* vt = lds + LDS_VT + (c8 * 8) * VT_STRIDE + r * 2;
            *(LAS bf16_t*)(vt + 0 * VT_STRIDE) = (bf16_t)(vv.x & 0xffffu); *(LAS bf16_t*)(vt + 1 * VT_STRIDE) = (bf16_t)(vv.x >> 16);
            *(LAS bf16_t*)(vt + 2 * VT_STRIDE) = (bf16_t)(vv.y & 0xffffu); *(LAS bf16_t*)(vt + 3 * VT_STRIDE) = (bf16_t)(vv.y >> 16);
            *(LAS bf16_t*)(vt + 4 * VT_STRIDE) = (bf16_t)(vv.z & 0xffffu); *(LAS bf16_t*)(vt + 5 * VT_STRIDE) = (bf16_t)(vv.z >> 16);
            *(LAS bf16_t*)(vt + 6 * VT_STRIDE) = (bf16_t)(vv.w & 0xffffu); *(LAS bf16_t*)(vt + 7 * VT_STRIDE) = (bf16_t)(vv.w >> 16);
        }
        __syncthreads();
        const int hl = wave >> 1, head = kvh * 4 + hl;
#pragma unroll 1
        for (int i = 0; i < 4; ++i) {
            const int qg = (wave & 1) * 4 + i, qi0 = 16 * qg, key0 = 16 * (qg & ~1);
            const size_t row = (size_t)b * SEQ + nb * WIN + qi0 + l15;
            const bf16_t* qp = Qb + row * DA + head * 64 + 8 * g;
            const bf16x8 q0 = *(const bf16x8*)qp, q1 = *(const bf16x8*)(qp + 32);
            attn_group(lds, key0, q0, q1, qi0 + l15 + WIN - key0, nb == 0 ? WIN : 0, hl, ATT + row * DA + head * 64, lane);
        }
    }
    for (int u = blockIdx.x; u < DBATCH * 4; u += F.G) {
        const int b = u >> 2, kvh = u & 3;
        __syncthreads();
        {
            const int hl = tid >> 7, dist = tid & 127;
            ((LAS float*)(lds + LDS_LUT))[tid] = a.rel_bias[T5_BUCKET[dist] * 16 + kvh * 4 + hl];
            if (tid < 4) ((LAS float*)(lds + LDS_SINK))[tid] = a.sinks[kvh * 4 + tid];
        }
#pragma unroll
        for (int i = 0; i < 4; ++i) {
            const int id = tid + 512 * i, j = id >> 4, c4 = id & 15;
            const size_t off = ((size_t)(b * WIN + j) * 4 + kvh) * 64 + c4 * 4;
            const f32x4 kf = *(const f32x4*)(a.cache_k + off), vf = *(const f32x4*)(a.cache_v + off);
            u32x2 kw; kw.x = cvt_pk_bf16(kf[0], kf[1]); kw.y = cvt_pk_bf16(kf[2], kf[3]);
            *(LAS u32x2*)(lds + LDS_KIMG + j * KIMG_STRIDE + c4 * 8) = kw;
            const unsigned v01 = cvt_pk_bf16(vf[0], vf[1]), v23 = cvt_pk_bf16(vf[2], vf[3]);
            LAS unsigned char* vt = lds + LDS_VT + (c4 * 4) * VT_STRIDE + j * 2;
            *(LAS bf16_t*)(vt + 0 * VT_STRIDE) = (bf16_t)(v01 & 0xffffu); *(LAS bf16_t*)(vt + 1 * VT_STRIDE) = (bf16_t)(v01 >> 16);
            *(LAS bf16_t*)(vt + 2 * VT_STRIDE) = (bf16_t)(v23 & 0xffffu); *(LAS bf16_t*)(vt + 3 * VT_STRIDE) = (bf16_t)(v23 >> 16);
        }
        if (tid < 256) {
            const int r = WIN + (tid >> 3), c8 = tid & 7;
            u32x4 kv = (u32x4){0u, 0u, 0u, 0u}, vv = (u32x4){0u, 0u, 0u, 0u};
            if (r < WIN + DSEQ) { const size_t off = (size_t)(MP + b * DSEQ + (r - WIN)) * DKV + kvh * 64 + c8 * 8; kv = *(const u32x4*)(Kb + off); vv = *(const u32x4*)(Vb + off); }
            *(LAS u32x4*)(lds + LDS_KIMG + r * KIMG_STRIDE + c8 * 16) = kv;
            LAS unsigned char* vt = lds + LDS_VT + (c8 * 8) * VT_STRIDE + r * 2;
            *(LAS bf16_t*)(vt + 0 * VT_STRIDE) = (bf16_t)(vv.x & 0xffffu); *(LAS bf16_t*)(vt + 1 * VT_STRIDE) = (bf16_t)(vv.x >> 16);
            *(LAS bf16_t*)(vt + 2 * VT_STRIDE) = (bf16_t)(vv.y & 0xffffu); *(LAS bf16_t*)(vt + 3 * VT_STRIDE) = (bf16_t)(vv.y >> 16);
            *(LAS bf16_t*)(vt + 4 * VT_STRIDE) = (bf16_t)(vv.z & 0xffffu); *(LAS bf16_t*)(vt + 5 * VT_STRIDE) = (bf16_t)(vv.z >> 16);
            *(LAS bf16_t*)(vt + 6 * VT_STRIDE) = (bf16_t)(vv.w & 0xffffu); *(LAS bf16_t*)(vt + 7 * VT_STRIDE) = (bf16_t)(vv.w >> 16);
        }
        __syncthreads();
        if (wave < 2) {
            const int t = l15 & 7, hl = 2 * wave + (l15 >> 3), head = kvh * 4 + hl;
            const size_t row = (size_t)MP + b * DSEQ + t;
            const bf16_t* qp = Qb + row * DA + head * 64 + 8 * g;
            const bf16x8 q0 = *(const bf16x8*)qp, q1 = *(const bf16x8*)(qp + 32);
            attn_group(lds, 0, q0, q1, t + WIN, 0, hl, ATT + row * DA + head * 64, lane);
        }
    }
    __syncthreads();
    {
        const bf16_t* U = (const bf16_t*)(ws + WS_U); const bf16_t* Bg = (const bf16_t*)(ws + WS_BG); bf16_t* AC = (bf16_t*)(ws + WS_ACONV);
        for (int id = blockIdx.x * (NWAVES * 64) + tid; id < M * (DC / 8); id += F.G * (NWAVES * 64)) {
            const int row = id >> 7, c = (id & 127) * 8;
            f32x4 u2a, u2b, u1a, u1b, u0a, u0b, ba, bb;
            pg8::unpack8(*(const u32x4*)(U + (size_t)row * DC + c), u0a, u0b);
            pg8::unpack8(*(const u32x4*)(Bg + (size_t)row * DC + c), ba, bb);
            int t; const float* st = nullptr;
            if (row < MP) t = row & (SEQ - 1); else { const int s = row - MP; t = s & 7; st = a.state_conv + (size_t)(s >> 3) * 2 * DC + c; }
            if (t >= 1) pg8::unpack8(*(const u32x4*)(U + (size_t)(row - 1) * DC + c), u1a, u1b);
            else if (st) { u1a = *(const f32x4*)(st + DC); u1b = *(const f32x4*)(st + DC + 4); }
            else { u1a = (f32x4){0.f, 0.f, 0.f, 0.f}; u1b = u1a; }
            if (t >= 2) pg8::unpack8(*(const u32x4*)(U + (size_t)(row - 2) * DC + c), u2a, u2b);
            else if (st) { const float* p = st + (t == 1 ? DC : 0); u2a = *(const f32x4*)p; u2b = *(const f32x4*)(p + 4); }
            else { u2a = (f32x4){0.f, 0.f, 0.f, 0.f}; u2b = u2a; }
            const f32x4 w0a = *(const f32x4*)(a.w_conv + c), w0b = *(const f32x4*)(a.w_conv + c + 4), w1a = *(const f32x4*)(a.w_conv + DC + c), w1b = *(const f32x4*)(a.w_conv + DC + c + 4),
                        w2a = *(const f32x4*)(a.w_conv + 2 * DC + c), w2b = *(const f32x4*)(a.w_conv + 2 * DC + c + 4);
            const f32x4 oa = ba * (w0a * u2a + w1a * u1a + w2a * u0a), ob = bb * (w0b * u2b + w1b * u1b + w2b * u0b);
            *(u32x4*)(AC + (size_t)row * DC + c) = pg8::pack8(oa, ob);
        }
    }
}

__device__ __forceinline__ void p7_final_norm(const Frame& F, const Args& a) {
    const int gw = F.vcu * NWAVES + F.wave, NGW = F.G * NWAVES;
    for (int m = gw; m < M; m += NGW) {
        f32x4* xr = (f32x4*)(a.out + OUT_Y + (size_t)m * D) + F.lane; const f32x4* gr = (const f32x4*)a.g_final + F.lane;
        f32x4 v[8]; float s = 0.f;
#pragma unroll
        for (int j = 0; j < 8; ++j) { v[j] = xr[64 * j]; s += (v[j][0] * v[j][0] + v[j][1] * v[j][1]) + (v[j][2] * v[j][2] + v[j][3] * v[j][3]); }
        const float rstd = __builtin_amdgcn_rsqf(wave_sum(s) * (1.0f / D) + EPS);
#pragma unroll
        for (int j = 0; j < 8; ++j) xr[64 * j] = v[j] * rstd * gr[64 * j];
    }
}

constexpr int N_PHASES = 8;
__global__ void __launch_bounds__(NWAVES * 64, 2) fwd_kernel(Args args) {
    extern __shared__ __attribute__((aligned(16))) unsigned char lds_raw[];
    Frame F;
    F.lds = (LAS unsigned char*)lds_raw;
    F.tid = threadIdx.x; F.lane = F.tid & 63; F.wave = __builtin_amdgcn_readfirstlane(F.tid >> 6);
    F.G = gridDim.x; { const int bx = blockIdx.x; F.vcu = (F.G % 8 == 0) ? (bx % 8) * (F.G / 8) + bx / 8 : bx; }
    unsigned char* ws = args.ws;
    unsigned* ctl = (unsigned*)(ws + WS_CTL);
    volatile LAS unsigned* MISC = (volatile LAS unsigned*)(F.lds + MISC_OFF);
    for (int u = F.tid; u < (LDS_BYTES - LDSCTL_OFF) / 4; u += NWAVES * 64) ((LAS unsigned*)(F.lds + LDSCTL_OFF))[u] = 0u;
    __syncthreads();
    XcdBarrier bar; bar.bar = ctl + CW_BAR; bar.x = 0; bar.st = nullptr;
    if (MK_N_LAUNCHES == 1) bar = xcd_barrier_post(ctl + CW_BAR, MISC + 8);
    const int lo = args.ph_lo, hi = args.ph_hi;
#define IN(k) (lo <= (k) && (k) < hi)
#define SEAM(k) do { if (IN(k) && IN((k) + 1)) xcd_barrier(bar); } while (0)
    float* rowss = (float*)(ctl + CW_ROWSS);

    if (IN(0)) { p0_prologue(F, args); SEAM(0); }
    if (IN(1)) {
        pg8::SchedG S; S.o.init(M / 256, NIN / 256, F.G, (int)blockIdx.x); S.A = (const char*)(ws + WS_XN); S.B = (const char*)(ws + WS_WIN); S.tstep = (size_t)256 * D * 2;
        pg8::EpiIn E{(bf16_t*)(ws + WS_BG), (bf16_t*)(ws + WS_U), (bf16_t*)(ws + WS_Q), (bf16_t*)(ws + WS_K), (bf16_t*)(ws + WS_V), (bf16_t*)(ws + WS_SG1), (bf16_t*)(ws + WS_SG2), args.out};
        pg8::gemm_phase(F.lds, D, S, E);
        SEAM(1);
    }
    if (IN(2)) { p2_attention_conv(F, args); SEAM(2); }
    if (IN(3)) {
        pg8::SchedMix S; S.o.init(M / 256, D / 256, F.G, (int)blockIdx.x);
        S.A0 = (const char*)(ws + WS_ACONV); S.A1 = (const char*)(ws + WS_ATT); S.B0 = (const char*)(ws + WS_WC); S.B1 = (const char*)(ws + WS_WA); S.tstep = (size_t)256 * DC * 2;
        pg8::EpiMix E{(bf16_t*)(ws + WS_SG1), (bf16_t*)(ws + WS_SG2)};
        pg8::gemm_phase(F.lds, DC, S, E);
        SEAM(3);
    }
    if (IN(4)) {
        pg8::SchedG S; S.o.init(M / 256, D / 256, F.G, (int)blockIdx.x); S.A = (const char*)(ws + WS_SG1); S.B = (const char*)(ws + WS_WO); S.tstep = (size_t)256 * D * 2;
        pg8::EpiWo E{args.x_prompt, args.x_sample, args.out + OUT_Y, (bf16_t*)(ws + WS_SG2), rowss};
        pg8::gemm_phase(F.lds, D, S, E);
        SEAM(4);
    }
    if (IN(5)) {
        pg8::SchedG S; S.o.init(M / 256, NGU / 256, F.G, (int)blockIdx.x); S.A = (const char*)(ws + WS_SG2); S.B = (const char*)(ws + WS_WGU); S.tstep = (size_t)256 * D * 2;
        pg8::EpiGU E{(bf16_t*)(ws + WS_ACT), rowss};
        pg8::gemm_phase(F.lds, D, S, E);
        SEAM(5);
    }
    if (IN(6)) {
        pg8::SchedG S; S.o.init(M / 256, D / 256, F.G, (int)blockIdx.x); S.A = (const char*)(ws + WS_ACT); S.B = (const char*)(ws + WS_WD); S.tstep = (size_t)256 * FF * 2;
        pg8::EpiDown E{args.out + OUT_Y};
        pg8::gemm_phase(F.lds, FF, S, E);
        SEAM(6);
    }
    if (IN(7)) { p7_final_norm(F, args); }
#undef IN
#undef SEAM
}

extern "C" void kernel_launch(void* const* d_in, const int* in_sizes, int n_in, void* d_out, int out_size, void* d_ws, size_t ws_size, hipStream_t stream) {
    static int grid = 0;
    if (grid == 0) {
        if (n_in != 18 || (size_t)out_size != OUT_END || ws_size < WS_END) { fprintf(stderr, "kernel_launch: unexpected shapes: n_in %d out %d ws %zu (need %zu)\n", n_in, out_size, ws_size, (size_t)WS_END); grid = -1; return; }
        int dev = 0, cus = 0, per_cu = 0;
        if (hipGetDevice(&dev) != hipSuccess || hipDeviceGetAttribute(&cus, hipDeviceAttributeMultiprocessorCount, dev) != hipSuccess) { grid = -1; return; }
        if (hipFuncSetAttribute((const void*)fwd_kernel, hipFuncAttributeMaxDynamicSharedMemorySize, LDS_BYTES) != hipSuccess) { fprintf(stderr, "kernel_launch: hipFuncSetAttribute failed\n"); grid = -1; return; }
        if (hipOccupancyMaxActiveBlocksPerMultiprocessor(&per_cu, (const void*)fwd_kernel, NWAVES * 64, LDS_BYTES) != hipSuccess || per_cu < 1) { fprintf(stderr, "kernel_launch: occupancy query says %d blocks per CU\n", per_cu); per_cu = 1; }
        (void)hipGetLastError();
        grid = cus;
    }
    if (grid < 0) return;
    (void)hipMemsetAsync((char*)d_ws + WS_CTL, 0, CTL_ZERO_BYTES, stream);
    Args a{};
    a.x_prompt = (const float*)d_in[0]; a.x_sample = (const float*)d_in[1]; a.cache_k = (const float*)d_in[2]; a.cache_v = (const float*)d_in[3]; a.state_conv = (const float*)d_in[4];
    a.rel_bias = (const float*)d_in[5]; a.w_in = (const float*)d_in[6]; a.w_conv = (const float*)d_in[7]; a.w_conv_out = (const float*)d_in[8]; a.sinks = (const float*)d_in[9];
    a.w_attn_out = (const float*)d_in[10]; a.w_o = (const float*)d_in[11]; a.g_mix = (const float*)d_in[12]; a.g_ffn = (const float*)d_in[13]; a.w_gate = (const float*)d_in[14];
    a.w_up = (const float*)d_in[15]; a.w_down = (const float*)d_in[16]; a.g_final = (const float*)d_in[17];
    a.out = (float*)d_out; a.ws = (unsigned char*)d_ws;
    if (MK_N_LAUNCHES == 1) {
        a.ph_lo = 0; a.ph_hi = N_PHASES;
        void* kargs[] = {&a};
        hipError_t e = hipLaunchCooperativeKernel((const void*)fwd_kernel, dim3(grid), dim3(NWAVES * 64), kargs, LDS_BYTES, stream);
        if (e != hipSuccess) fprintf(stderr, "kernel_launch: cooperative launch failed: %s (grid %d)\n", hipGetErrorString(e), grid);
    } else {
        for (int p = 0; p < N_PHASES; ++p) {
            a.ph_lo = p; a.ph_hi = p + 1;
            hipLaunchKernelGGL(fwd_kernel, dim3(grid), dim3(NWAVES * 64), LDS_BYTES, stream, a);
        }
    }
}
```

```cpp
#include <hip/hip_runtime.h>
#include <cstdio>
#include <cstdint>

#ifndef MK_N_LAUNCHES
#define MK_N_LAUNCHES 1
#endif

#define LAS __attribute__((address_space(3)))
#define GAS __attribute__((address_space(1)))
typedef unsigned short bf16_t;
typedef short bf16x8 __attribute__((ext_vector_type(8)));
typedef float f32x4 __attribute__((ext_vector_type(4)));
typedef unsigned u32x4 __attribute__((ext_vector_type(4)));
typedef unsigned u32x2 __attribute__((ext_vector_type(2)));

constexpr int D = 2048, DC = 1024, DA = 1024, DKV = 256, NIN = 8704, FF = 5632, NGU = 2 * FF;
constexpr int MP = 8192, MS = 1024, M = MP + MS;
constexpr int SEQ = 2048, NBATCH = 4, DBATCH = 128, DSEQ = 8, WIN = 128;
constexpr float EPS = 1e-6f;
constexpr size_t OUT_Y = 0, OUT_KP = (size_t)M * D, OUT_VP = OUT_KP + 131072, OUT_CP = OUT_VP + 131072, OUT_KS = OUT_CP + 8192,
                 OUT_VS = OUT_KS + 4194304, OUT_CS = OUT_VS + 4194304, OUT_END = OUT_CS + 262144;
constexpr size_t MiB = 1u << 20;
constexpr size_t WS_CTL = 0, CTL_ZERO_BYTES = 1 * MiB;
constexpr size_t WS_WIN = 1 * MiB, WS_WC = 35 * MiB, WS_WA = 39 * MiB, WS_WO = 43 * MiB, WS_WGU = 51 * MiB, WS_WD = 95 * MiB;
constexpr size_t WS_XN = 117 * MiB, WS_ACONV = WS_XN, WS_ATT = WS_XN + 18 * MiB;
constexpr size_t WS_BG = 153 * MiB, WS_U = 171 * MiB, WS_Q = 189 * MiB, WS_K = 207 * MiB, WS_V = WS_K + (size_t)M * DKV * 2;
constexpr size_t WS_ACT = WS_XN;
constexpr size_t WS_SG1 = 216 * MiB, WS_SG2 = 252 * MiB;
constexpr size_t WS_END = 288 * MiB;
static_assert(WS_V + (size_t)M * DKV * 2 == 216 * MiB && WS_ACT + (size_t)M * FF * 2 == 216 * MiB, "ws map");
constexpr int CW_BAR = 4096;
constexpr int CW_ROWSS = 32768;

constexpr int RING_BYTES = 131072;
constexpr int LDSCTL_OFF = RING_BYTES, MISC_OFF = LDSCTL_OFF + 320;
constexpr int LDS_BYTES = 147456;
constexpr int NWAVES = 8;

#define LDS_WAIT() asm volatile("s_waitcnt lgkmcnt(0)" ::: "memory")
#define VM_WAIT() asm volatile("s_waitcnt vmcnt(0)" ::: "memory")
typedef float f32x2_t __attribute__((ext_vector_type(2))); typedef __bf16 bf16x2_t __attribute__((ext_vector_type(2)));
__device__ __forceinline__ unsigned cvt_pk_bf16(float lo, float hi) { const f32x2_t v = {lo, hi}; const bf16x2_t b = __builtin_convertvector(v, bf16x2_t); return __builtin_bit_cast(unsigned, b); }
__device__ __forceinline__ float bf_lo(unsigned w) { return __builtin_bit_cast(float, w << 16); }
__device__ __forceinline__ float bf_hi(unsigned w) { return __builtin_bit_cast(float, w & 0xffff0000u); }
__device__ __forceinline__ float fsigmoid(float x) { return __builtin_amdgcn_rcpf(1.0f + __expf(-x)); }
__device__ __forceinline__ float wave_sum(float v) {
#pragma unroll
    for (int o = 1; o < 64; o <<= 1) v += __shfl_xor(v, o);
    return v;
}

namespace pg8 {
constexpr int BM = 256, BK = 64, HALF = 128, HTB = HALF * BK * 2, STAGE_BYTES = 8 * HTB, NXCD = 8, WGM = 8;
__host__ __device__ __forceinline__ int lds_byte(int r, int c) { const int st = (r >> 4) * 2 + (c >> 5), rr = r & 15, cc = c & 31, ob = rr * 64 + cc * 2; return st * 1024 + (ob ^ (((ob >> 9) & 1) << 5)); }
__host__ __device__ __forceinline__ void stage_rc(int b, int& R, int& C) { const int st = b / 1024, sb = b % 1024, swz = sb ^ (((sb >> 9) & 1) << 5); R = (st >> 1) * 16 + swz / 64; C = (st & 1) * 32 + (swz % 64) / 2; }
__host__ __device__ __forceinline__ int perm32(int rho) { const int n = rho >> 4, i = rho & 15; return 8 * (i >> 2) + 4 * n + (i & 3); }

struct Unit { int pm, pn, aux; };
struct OrderMap {
    int nM, nN, nwg, G, c;
    __device__ __forceinline__ void init(int nM_, int nN_, int G_, int c_) { nM = nM_; nN = nN_; nwg = nM * nN; G = G_; c = c_; }
    __device__ __forceinline__ bool tile(int i, int& pm, int& pn) const {
        const long L = (long)i * G + c; if (L >= nwg) return false;
        int wgid = (int)L; { const int q = nwg / NXCD, r = nwg % NXCD, xcd = wgid % NXCD, off = wgid / NXCD; wgid = (xcd < r ? xcd * (q + 1) : r * (q + 1) + (xcd - r) * q) + off; }
        const int nig = WGM * nN, gid = wgid / nig, fm = gid * WGM, gsz = (nM - fm) < WGM ? (nM - fm) : WGM;
        pm = fm + ((wgid % nig) % gsz); pn = (wgid % nig) / gsz; return true;
    }
};
struct SchedG {
    OrderMap o; const char* A; const char* B; size_t tstep;
    __device__ __forceinline__ bool next(int i, Unit& u) const { u.aux = 0; return o.tile(i, u.pm, u.pn); }
    __device__ __forceinline__ const char* a_ptr(const Unit& u) const { return A + (size_t)u.pm * tstep; }
    __device__ __forceinline__ const char* b_ptr(const Unit& u) const { return B + (size_t)u.pn * tstep; }
};
struct SchedMix {
    OrderMap o; const char *A0, *A1, *B0, *B1; size_t tstep;
    __device__ __forceinline__ bool next(int i, Unit& u) const { u.aux = i & 1; return o.tile(i >> 1, u.pm, u.pn); }
    __device__ __forceinline__ const char* a_ptr(const Unit& u) const { return (u.aux ? A1 : A0) + (size_t)u.pm * tstep; }
    __device__ __forceinline__ const char* b_ptr(const Unit& u) const { return (u.aux ? B1 : B0) + (size_t)u.pn * tstep; }
};

template <class Epi, class Sched>
__device__ __forceinline__ void gemm_phase(LAS unsigned char* lds, const int K, const Sched& S, const Epi& E) {
    const int tid = threadIdx.x, wid = __builtin_amdgcn_readfirstlane(tid >> 6), lane = tid & 63, wr = wid >> 2, wc = wid & 3, fr = lane & 15, fq = lane >> 4;
    const int nt = K / BK;
    unsigned voffA[2], voffB[2];
#pragma unroll
    for (int i = 0; i < 2; ++i) { int R, C; stage_rc(tid * 16 + i * 8192, R, C); const int Rb = (R & ~31) + perm32(R & 31);
        voffA[i] = (unsigned)(R * K + C) * 2u; voffB[i] = (unsigned)(Rb * K + C) * 2u; }
    const size_t kstep = (size_t)(BK * 2);
    const size_t hstep = (size_t)HALF * K * 2;
    const unsigned ldsw = (unsigned)wid * 1024u;
    const int aoff = lds_byte(wr * 64 + fr, fq * 8), boff = lds_byte(wc * 32 + fr, fq * 8);
#define PG8_SA(b, h) (((b) * 2 + (h)) * HTB)
#define PG8_SB(b, h) ((4 + (b) * 2 + (h)) * HTB)
#define PG8_STAGE(bufoff, gbase, voff) do { _Pragma("unroll") for (int _i = 0; _i < 2; ++_i) \
        __builtin_amdgcn_global_load_lds((const unsigned*)((const char*)(gbase) + (voff)[_i]), (LAS unsigned*)(lds + (bufoff) + ldsw + _i * 8192), 16, 0, 0); } while (0)
#define PG8_LDA(dst, b, h) do { _Pragma("unroll") for (int m = 0; m < 4; ++m) _Pragma("unroll") for (int k = 0; k < 2; ++k) dst[m][k] = *(const LAS bf16x8*)(lds + PG8_SA(b, h) + aoff + m * 2048 + k * 1024); } while (0)
#define PG8_LDB(dst, b, h) do { _Pragma("unroll") for (int n = 0; n < 2; ++n) _Pragma("unroll") for (int k = 0; k < 2; ++k) dst[n][k] = *(const LAS bf16x8*)(lds + PG8_SB(b, h) + boff + n * 2048 + k * 1024); } while (0)
#define PG8_MMA(ai, bj, At, Bt) do { __builtin_amdgcn_s_setprio(1); _Pragma("unroll") for (int m = 0; m < 4; ++m) _Pragma("unroll") for (int n = 0; n < 2; ++n) _Pragma("unroll") for (int k = 0; k < 2; ++k) \
        acc[ai][bj][m][n] = __builtin_amdgcn_mfma_f32_16x16x32_bf16(Bt[n][k], At[m][k], acc[ai][bj][m][n], 0, 0, 0); __builtin_amdgcn_s_setprio(0); } while (0)
#define PG8_WAIT_V(n) asm volatile("s_waitcnt vmcnt(" #n ")" ::: "memory")
#define PG8_WAIT_L(n) asm volatile("s_waitcnt lgkmcnt(" #n ")" ::: "memory")
#define PG8_BAR __builtin_amdgcn_s_barrier()
#define PG8_SCHED __builtin_amdgcn_sched_barrier(0)
    Unit cur, nxt; int ui = 0;
    if (!S.next(0, cur)) return;
    f32x4 acc[2][2][4][2];
#pragma unroll
    for (int a = 0; a < 2; ++a)
#pragma unroll
        for (int b = 0; b < 2; ++b)
#pragma unroll
            for (int m = 0; m < 4; ++m)
#pragma unroll
                for (int n = 0; n < 2; ++n) acc[a][b][m][n] = (f32x4){0.f, 0.f, 0.f, 0.f};
    bf16x8 At[4][2], B0[2][2], B1[2][2];
    const char* cA = S.a_ptr(cur); const char* cB = S.b_ptr(cur);
    PG8_STAGE(PG8_SB(0, 0), cB, voffB); PG8_STAGE(PG8_SB(0, 1), cB + hstep, voffB); PG8_STAGE(PG8_SA(0, 0), cA, voffA); PG8_STAGE(PG8_SA(0, 1), cA + hstep, voffA);
    if (wr == 1) PG8_BAR;
    PG8_WAIT_V(2); PG8_BAR;
    PG8_STAGE(PG8_SB(1, 0), cB + kstep, voffB); PG8_STAGE(PG8_SA(1, 0), cA + kstep, voffA); PG8_STAGE(PG8_SB(1, 1), cB + hstep + kstep, voffB);
    PG8_WAIT_V(6); PG8_BAR;
    for (;;) {
        const bool has_next = S.next(ui + 1, nxt);
        const char* nA = has_next ? S.a_ptr(nxt) : cA; const char* nB = has_next ? S.b_ptr(nxt) : cB;
        for (int t = 0; t < nt; t += 2) {
            const bool last = (t == nt - 2);
            const char* a1 = cA + (size_t)(t + 1) * kstep;
            const char* a2 = last ? nA : cA + (size_t)(t + 2) * kstep; const char* b2 = last ? nB : cB + (size_t)(t + 2) * kstep;
            const char* a3 = a2 + kstep; const char* b3 = b2 + kstep;
            PG8_LDB(B0, 0, 0); PG8_LDB(B1, 0, 1); PG8_SCHED; PG8_LDA(At, 0, 0); PG8_STAGE(PG8_SA(1, 1), a1 + hstep, voffA);
            PG8_WAIT_V(8); PG8_WAIT_L(0); PG8_BAR; PG8_MMA(0, 0, At, B0); PG8_MMA(0, 1, At, B1); PG8_BAR; PG8_SCHED;
            PG8_LDA(At, 0, 1); PG8_STAGE(PG8_SB(0, 0), b2, voffB); PG8_STAGE(PG8_SB(0, 1), b2 + hstep, voffB); PG8_STAGE(PG8_SA(0, 0), a2, voffA);
            PG8_WAIT_V(8); PG8_WAIT_L(0); PG8_BAR; PG8_MMA(1, 0, At, B0); PG8_MMA(1, 1, At, B1); PG8_BAR; PG8_SCHED;
            PG8_LDB(B0, 1, 0); PG8_LDB(B1, 1, 1); PG8_SCHED; PG8_LDA(At, 1, 0); PG8_STAGE(PG8_SA(0, 1), a2 + hstep, voffA);
            PG8_WAIT_V(8); PG8_WAIT_L(0); PG8_BAR; PG8_MMA(0, 0, At, B0); PG8_MMA(0, 1, At, B1); PG8_BAR; PG8_SCHED;
            PG8_LDA(At, 1, 1); PG8_STAGE(PG8_SB(1, 0), b3, voffB); PG8_STAGE(PG8_SB(1, 1), b3 + hstep, voffB); PG8_STAGE(PG8_SA(1, 0), a3, voffA);
            PG8_WAIT_V(8); PG8_WAIT_L(0); PG8_BAR; PG8_MMA(1, 0, At, B0); PG8_MMA(1, 1, At, B1); PG8_BAR; PG8_SCHED;
        }
        if (wr == 0) PG8_BAR;
        E(acc, cur, wr, wc, fr, fq);
        if (!has_next) break;
        if (!E.keep(cur)) {
#pragma unroll
            for (int a = 0; a < 2; ++a)
#pragma unroll
                for (int b = 0; b < 2; ++b)
#pragma unroll
                    for (int m = 0; m < 4; ++m)
#pragma unroll
                        for (int n = 0; n < 2; ++n) acc[a][b][m][n] = (f32x4){0.f, 0.f, 0.f, 0.f};
        }
        cur = nxt; cA = nA; cB = nB; ++ui;
        if (wr == 1) PG8_BAR;
    }
    PG8_WAIT_V(0);
    PG8_BAR;
#undef PG8_SA
#undef PG8_SB
#undef PG8_STAGE
#undef PG8_LDA
#undef PG8_LDB
#undef PG8_MMA
#undef PG8_WAIT_V
#undef PG8_WAIT_L
#undef PG8_BAR
#undef PG8_SCHED
}

__device__ __forceinline__ u32x4 pack8(const f32x4 v0, const f32x4 v1) { u32x4 w; w.x = cvt_pk_bf16(v0[0], v0[1]); w.y = cvt_pk_bf16(v0[2], v0[3]); w.z = cvt_pk_bf16(v1[0], v1[1]); w.w = cvt_pk_bf16(v1[2], v1[3]); return w; }
__device__ __forceinline__ void unpack8(const u32x4 w, f32x4& v0, f32x4& v1) { v0 = (f32x4){bf_lo(w.x), bf_hi(w.x), bf_lo(w.y), bf_hi(w.y)}; v1 = (f32x4){bf_lo(w.z), bf_hi(w.z), bf_lo(w.w), bf_hi(w.w)}; }

struct EpiIn {
    bf16_t *Bg, *U, *Q, *Kb, *Vb, *SG1, *SG2; float* out;
    __device__ __forceinline__ bool keep(const Unit&) const { return false; }
    __device__ __forceinline__ void operator()(f32x4 (&acc)[2][2][4][2], const Unit& u, int wr, int wc, int fr, int fq) const {
        const int pn = u.pn, row0 = u.pm * BM + wr * 64 + fr, cl = wc * 32 + 8 * fq;
        if (pn >= 4 && pn < 12) {
            const int ch = 128 * (pn - 4) + cl;
#pragma unroll
            for (int ai = 0; ai < 2; ++ai)
#pragma unroll
                for (int m = 0; m < 4; ++m) {
                    const int row = row0 + ai * HALF + m * 16;
                    const f32x4 u0 = acc[ai][0][m][0] * acc[ai][1][m][0], u1 = acc[ai][0][m][1] * acc[ai][1][m][1];
                    *(u32x4*)(U + (size_t)row * DC + ch) = pack8(u0, u1);
                    bool st; size_t idx;
                    if (row < MP) { const int t = row & (SEQ - 1); st = t >= SEQ - 2; idx = OUT_CP + (size_t)((row >> 11) * 2 + (t - (SEQ - 2))) * DC + ch; }
                    else { const int s = row - MP, t = s & 7; st = t >= 6; idx = OUT_CS + (size_t)((s >> 3) * 2 + (t - 6)) * DC + ch; }
                    if (st) { *(f32x4*)(out + idx) = u0; *(f32x4*)(out + idx + 4) = u1; }
                }
            return;
        }
        bf16_t* dst; int ld, col0; float sc = 1.f; bool sig = false; int side = 0;
        if (pn < 4) { dst = Bg; ld = DC; col0 = 256 * pn; }
        else if (pn < 16) { dst = Q; ld = DA; col0 = 256 * (pn - 12); sc = 0.125f; }
        else if (pn == 16) { dst = Kb; ld = DKV; col0 = 0; side = 1; }
        else if (pn == 17) { dst = Vb; ld = DKV; col0 = 0; side = 2; }
        else if (pn < 26) { dst = SG1; ld = D; col0 = 256 * (pn - 18); sig = true; }
        else { dst = SG2; ld = D; col0 = 256 * (pn - 26); sig = true; }
#pragma unroll
        for (int ai = 0; ai < 2; ++ai)
#pragma unroll
            for (int m = 0; m < 4; ++m) {
                const int row = row0 + ai * HALF + m * 16;
                bool st = false; size_t sidx = 0;
                if (side) {
                    if (row < MP) { const int t = row & (SEQ - 1); st = t >= SEQ - WIN; sidx = (side == 1 ? OUT_KP : OUT_VP) + (size_t)((row >> 11) * WIN + (t - (SEQ - WIN))) * DKV; }
                    else { const int s = row - MP; st = true; sidx = (side == 1 ? OUT_KS : OUT_VS) + (size_t)((s >> 3) * WIN + (WIN - DSEQ) + (s & 7)) * DKV; }
                }
#pragma unroll
                for (int bj = 0; bj < 2; ++bj) {
                    f32x4 v0 = acc[ai][bj][m][0], v1 = acc[ai][bj][m][1];
                    if (st) { *(f32x4*)(out + sidx + bj * HALF + cl) = v0; *(f32x4*)(out + sidx + bj * HALF + cl + 4) = v1; }
                    if (sig) {
#pragma unroll
                        for (int j = 0; j < 4; ++j) { v0[j] = fsigmoid(v0[j]); v1[j] = fsigmoid(v1[j]); }
                    } else { v0 = v0 * sc; v1 = v1 * sc; }
                    *(u32x4*)(dst + (size_t)row * ld + col0 + bj * HALF + cl) = pack8(v0, v1);
                }
            }
    }
};
struct EpiMix {
    bf16_t *SG1, *SG2;
    __device__ __forceinline__ bool keep(const Unit& u) const { return u.aux == 0; }
    __device__ __forceinline__ void operator()(f32x4 (&acc)[2][2][4][2], const Unit& u, int wr, int wc, int fr, int fq) const {
        const int row0 = u.pm * BM + wr * 64 + fr, col0 = u.pn * BM + wc * 32 + 8 * fq;
        const bf16_t* g2 = SG2 + (size_t)row0 * D + col0; bf16_t* g1 = SG1 + (size_t)row0 * D + col0;
        if (u.aux == 0) {
#pragma unroll
            for (int s = 0; s < 8; ++s) { const int ai = s >> 2, m = s & 3; const size_t off = (size_t)(ai * HALF + m * 16) * D;
#pragma unroll
                for (int bj = 0; bj < 2; ++bj) {
                    f32x4 a0, a1, c0, c1; unpack8(*(const u32x4*)(g2 + off + bj * HALF), a0, a1); unpack8(*(const u32x4*)(g1 + off + bj * HALF), c0, c1);
#pragma unroll
                    for (int j = 0; j < 4; ++j) { acc[ai][bj][m][0][j] *= c0[j] * __builtin_amdgcn_rcpf(fmaxf(a0[j], 1e-30f)); acc[ai][bj][m][1][j] *= c1[j] * __builtin_amdgcn_rcpf(fmaxf(a1[j], 1e-30f)); }
                } }
        } else {
            u32x4 gv[2][2];
            gv[0][0] = *(const u32x4*)(g2); gv[0][1] = *(const u32x4*)(g2 + HALF);
#pragma unroll
            for (int s = 0; s < 8; ++s) { const int ai = s >> 2, m = s & 3; const size_t off = (size_t)(ai * HALF + m * 16) * D;
                if (s + 1 < 8) { const int ai2 = (s + 1) >> 2, m2 = (s + 1) & 3; const size_t off2 = (size_t)(ai2 * HALF + m2 * 16) * D;
                    gv[(s + 1) & 1][0] = *(const u32x4*)(g2 + off2); gv[(s + 1) & 1][1] = *(const u32x4*)(g2 + off2 + HALF); }
#pragma unroll
                for (int bj = 0; bj < 2; ++bj) { f32x4 a0, a1; unpack8(gv[s & 1][bj], a0, a1);
                    *(u32x4*)(g1 + off + bj * HALF) = pack8(acc[ai][bj][m][0] * a0, acc[ai][bj][m][1] * a1); }
            }
        }
    }
};
struct EpiWo {
    const float *xp, *xs; float* H; bf16_t* HB; float* rowss;
    __device__ __forceinline__ bool keep(const Unit&) const { return false; }
    __device__ __forceinline__ void operator()(f32x4 (&acc)[2][2][4][2], const Unit& u, int wr, int wc, int fr, int fq) const {
        const int row0 = u.pm * BM + wr * 64 + fr, col0 = u.pn * BM + wc * 32 + 8 * fq;
        const float* xb = ((u.pm < MP / BM) ? xp : xs - (size_t)MP * D) + (size_t)row0 * D + col0;
        float* hp = H + (size_t)row0 * D + col0; bf16_t* hb = HB + (size_t)row0 * D + col0; float* rs = rowss + row0;
        f32x4 xv[2][4];
#define WO_LD(s_, buf_) do { const size_t o_ = (size_t)(((s_) >> 2) * HALF + ((s_) & 3) * 16) * D; \
            xv[buf_][0] = *(const f32x4*)(xb + o_); xv[buf_][1] = *(const f32x4*)(xb + o_ + 4); xv[buf_][2] = *(const f32x4*)(xb + o_ + HALF); xv[buf_][3] = *(const f32x4*)(xb + o_ + HALF + 4); } while (0)
        WO_LD(0, 0);
#pragma unroll
        for (int s = 0; s < 8; ++s) { const int ai = s >> 2, m = s & 3; const size_t off = (size_t)(ai * HALF + m * 16) * D;
            if (s + 1 < 8) WO_LD(s + 1, (s + 1) & 1);
            const f32x4 h00 = xv[s & 1][0] + acc[ai][0][m][0], h01 = xv[s & 1][1] + acc[ai][0][m][1], h10 = xv[s & 1][2] + acc[ai][1][m][0], h11 = xv[s & 1][3] + acc[ai][1][m][1];
            *(f32x4*)(hp + off) = h00; *(f32x4*)(hp + off + 4) = h01; *(f32x4*)(hp + off + HALF) = h10; *(f32x4*)(hp + off + HALF + 4) = h11;
            *(u32x4*)(hb + off) = pack8(h00, h01); *(u32x4*)(hb + off + HALF) = pack8(h10, h11);
            float ss = (h00[0] * h00[0] + h00[1] * h00[1]) + (h00[2] * h00[2] + h00[3] * h00[3]) + (h01[0] * h01[0] + h01[1] * h01[1]) + (h01[2] * h01[2] + h01[3] * h01[3])
                     + (h10[0] * h10[0] + h10[1] * h10[1]) + (h10[2] * h10[2] + h10[3] * h10[3]) + (h11[0] * h11[0] + h11[1] * h11[1]) + (h11[2] * h11[2] + h11[3] * h11[3]);
            ss += __shfl_xor(ss, 16); ss += __shfl_xor(ss, 32);
            if (fq == 0) __hip_atomic_fetch_add(rs + ai * HALF + m * 16, ss, __ATOMIC_RELAXED, __HIP_MEMORY_SCOPE_AGENT);
        }
#undef WO_LD
    }
};
struct EpiGU {
    bf16_t* ACT; const float* rowss;
    __device__ __forceinline__ bool keep(const Unit&) const { return false; }
    __device__ __forceinline__ void operator()(f32x4 (&acc)[2][2][4][2], const Unit& u, int wr, int wc, int fr, int fq) const {
        const int row0 = u.pm * BM + wr * 64 + fr, ch = 128 * u.pn + wc * 32 + 8 * fq;
        float rstd[8];
#pragma unroll
        for (int s = 0; s < 8; ++s) rstd[s] = __hip_atomic_load(rowss + row0 + (s >> 2) * HALF + (s & 3) * 16, __ATOMIC_RELAXED, __HIP_MEMORY_SCOPE_AGENT);
#pragma unroll
        for (int s = 0; s < 8; ++s) rstd[s] = __builtin_amdgcn_rsqf(rstd[s] * (1.0f / D) + EPS);
#pragma unroll
        for (int ai = 0; ai < 2; ++ai)
#pragma unroll
            for (int m = 0; m < 4; ++m) {
                const int row = row0 + ai * HALF + m * 16; const float r = rstd[ai * 4 + m];
                f32x4 o[2];
#pragma unroll
                for (int n = 0; n < 2; ++n)
#pragma unroll
                    for (int j = 0; j < 4; ++j) { const float g = acc[ai][0][m][n][j] * r, up = acc[ai][1][m][n][j] * r; o[n][j] = g * fsigmoid(g) * up; }
                *(u32x4*)(ACT + (size_t)row * FF + ch) = pack8(o[0], o[1]);
            }
    }
};
struct EpiDown {
    float* H;
    __device__ __forceinline__ bool keep(const Unit&) const { return false; }
    __device__ __forceinline__ void operator()(f32x4 (&acc)[2][2][4][2], const Unit& u, int wr, int wc, int fr, int fq) const {
        const int row0 = u.pm * BM + wr * 64 + fr, col0 = u.pn * BM + wc * 32 + 8 * fq;
        float* hp = H + (size_t)row0 * D + col0;
        f32x4 xv[2][4];
#define DN_LD(s_, buf_) do { const size_t o_ = (size_t)(((s_) >> 2) * HALF + ((s_) & 3) * 16) * D; \
            xv[buf_][0] = *(const f32x4*)(hp + o_); xv[buf_][1] = *(const f32x4*)(hp + o_ + 4); xv[buf_][2] = *(const f32x4*)(hp + o_ + HALF); xv[buf_][3] = *(const f32x4*)(hp + o_ + HALF + 4); } while (0)
        DN_LD(0, 0);
#pragma unroll
        for (int s = 0; s < 8; ++s) { const int ai = s >> 2, m = s & 3; const size_t off = (size_t)(ai * HALF + m * 16) * D;
            if (s + 1 < 8) DN_LD(s + 1, (s + 1) & 1);
            *(f32x4*)(hp + off) = xv[s & 1][0] + acc[ai][0][m][0]; *(f32x4*)(hp + off + 4) = xv[s & 1][1] + acc[ai][0][m][1];
            *(f32x4*)(hp + off + HALF) = xv[s & 1][2] + acc[ai][1][m][0]; *(f32x4*)(hp + off + HALF + 4) = xv[s & 1][3] + acc[ai][1][m][1];
        }
#undef DN_LD
    }
};
}

#define XB_TMO      128
#define XB_XCNT(j)  (256  + 64 * (j))
#define XB_XSUB(j)  (1280 + 64 * (j))
#define XB_XGEN(j)  (2304 + 64 * (j))
#define XB_TOP      3328
#define XB_TOPGEN   3392
#define XCD_BAR_WORDS 3456
#define XB_SPIN_CAP (1u << 18)
__device__ __forceinline__ unsigned xb_ld(unsigned* p)              { return __hip_atomic_load(p, __ATOMIC_RELAXED, __HIP_MEMORY_SCOPE_AGENT); }
__device__ __forceinline__ unsigned xb_add(unsigned* p, unsigned v) { return __hip_atomic_fetch_add(p, v, __ATOMIC_RELAXED, __HIP_MEMORY_SCOPE_AGENT); }
__device__ __forceinline__ unsigned xb_xcc_id() { return (unsigned)__builtin_amdgcn_s_getreg((3 << 11) | 20) & 0xFu; }
#define XB_SPIN(cond, bar) do { unsigned _sp = 0; while (cond) { __builtin_amdgcn_s_sleep(1); \
    if ((++_sp & 255u) == 0u) { if (xb_ld(&(bar)[XB_TMO])) break; if (_sp > XB_SPIN_CAP) { atomicAdd(&(bar)[XB_TMO], 1u); break; } } } } while (0)
struct XcdBarrier { unsigned* bar; unsigned x; volatile LAS unsigned* st; };
__device__ __forceinline__ XcdBarrier xcd_barrier_post(unsigned* bar, volatile LAS unsigned* st) {
    XcdBarrier b; b.bar = bar; b.x = xb_xcc_id(); b.st = st;
    if (threadIdx.x == 0) (void)xb_add(&bar[XB_XCNT(b.x)], 1u);
    return b;
}
__device__ __forceinline__ void xcd_barrier_complete(unsigned* bar, unsigned x, unsigned& nloc, unsigned& nx) {
    const unsigned G = gridDim.x * gridDim.y * gridDim.z;
    unsigned sum, cnt, mine, sp = 0u;
    for (;;) {
        sum = 0u; cnt = 0u; mine = 0u;
#pragma unroll
        for (unsigned j = 0; j < 16; ++j) { const unsigned c = xb_ld(&bar[XB_XCNT(j)]); sum += c; cnt += (c > 0u) ? 1u : 0u; mine = (j == x) ? c : mine; }
        if (sum == G) break;
        __builtin_amdgcn_s_sleep(1);
        if ((++sp & 255u) == 0u) { if (xb_ld(&bar[XB_TMO])) break; if (sp > XB_SPIN_CAP) { atomicAdd(&bar[XB_TMO], 1u); break; } }
    }
    nloc = mine > 0u ? mine : 1u; nx = cnt > 0u ? cnt : 1u;
}
__device__ __forceinline__ void xcd_barrier(const XcdBarrier& b) {
    asm volatile("s_waitcnt vmcnt(0)" ::: "memory");
    __syncthreads();
    if (threadIdx.x == 0) {
        unsigned* bar = b.bar;
        __builtin_amdgcn_s_waitcnt(0);
        unsigned nloc = b.st[0], nx = b.st[1];
        if (nloc == 0u) { xcd_barrier_complete(bar, b.x, nloc, nx); b.st[0] = nloc; b.st[1] = nx; }
        const unsigned old = xb_add(&bar[XB_XSUB(b.x)], 1u);
        const unsigned gen = old / nloc;
        if (old + 1u == (gen + 1u) * nloc) {
            __builtin_amdgcn_fence(__ATOMIC_RELEASE, "agent");
            asm volatile("s_waitcnt vmcnt(0)" ::: "memory");
            const unsigned og = xb_add(&bar[XB_TOP], 1u);
            const unsigned tg = og / nx;
            if (og + 1u == (tg + 1u) * nx) xb_add(&bar[XB_TOPGEN], 1u);
            else XB_SPIN(xb_ld(&bar[XB_TOPGEN]) == tg, bar);
            __builtin_amdgcn_fence(__ATOMIC_ACQUIRE, "agent");
            xb_add(&bar[XB_XGEN(b.x)], 1u);
            asm volatile("s_waitcnt vmcnt(0)" ::: "memory");
        } else {
            XB_SPIN(xb_ld(&bar[XB_XGEN(b.x)]) == gen, bar);
            __builtin_amdgcn_fence(__ATOMIC_ACQUIRE, "agent");
            asm volatile("s_waitcnt vmcnt(0)" ::: "memory");
        }
    }
    __syncthreads();
}

struct Args {
    const float *x_prompt, *x_sample, *cache_k, *cache_v, *state_conv, *rel_bias, *w_in, *w_conv, *w_conv_out, *sinks, *w_attn_out, *w_o, *g_mix, *g_ffn, *w_gate, *w_up, *w_down, *g_final;
    float* out; unsigned char* ws; int ph_lo, ph_hi;
};
struct Frame { LAS unsigned char* lds; int tid, lane, wave, vcu, G; };

static __device__ const unsigned char T5_BUCKET[128] = {
    0, 1, 2, 3, 4, 5, 6, 7, 8, 9, 10, 11, 12, 13, 14, 15, 16, 16, 16, 17, 17, 18, 18, 18, 19, 19, 19, 20, 20, 20, 20, 21, 21, 21, 21, 22, 22, 22, 22, 22, 23, 23, 23, 23, 23, 23,
    24, 24, 24, 24, 24, 24, 25, 25, 25, 25, 25, 25, 25, 26, 26, 26, 26, 26, 26, 26, 26, 27, 27, 27, 27, 27, 27, 27, 27, 27, 27, 28, 28, 28, 28, 28, 28, 28, 28, 28, 28,
    29, 29, 29, 29, 29, 29, 29, 29, 29, 29, 29, 29, 30, 30, 30, 30, 30, 30, 30, 30, 30, 30, 30, 30, 30, 30, 31, 31, 31, 31, 31, 31, 31, 31, 31, 31, 31, 31, 31, 31, 31};

constexpr int P0_PITCH = 520;
struct P0Item { const float* W; bf16_t* WT; const float* gk; int K, N, k0, n0, dr; };
__device__ __forceinline__ bool p0_decode(const Args& a, unsigned char* ws, int it, P0Item& q) {
    constexpr int T_IN = (D / 128) * (NIN / 128), T_C = (DC / 128) * (D / 128), T_A = T_C, T_O = (D / 128) * (D / 128), T_G = (D / 128) * (FF / 128), T_U = T_G, T_D = (FF / 128) * (D / 128);
    int r = it; q.gk = nullptr;
    if (r < T_IN) { const int nb = NIN / 128; q.W = a.w_in; q.WT = (bf16_t*)(ws + WS_WIN); q.K = D; q.N = NIN; q.k0 = 128 * (r / nb); q.n0 = 128 * (r % nb);
        const int n0 = q.n0; q.dr = n0 < 1024 ? n0 : n0 < 2048 ? 1024 + 2 * (n0 - 1024) : n0 < 3072 ? 1024 + 2 * (n0 - 2048) + 128 : n0; return true; } r -= T_IN;
    if (r < T_C) { const int nb = D / 128; q.W = a.w_conv_out; q.WT = (bf16_t*)(ws + WS_WC); q.K = DC; q.N = D; q.k0 = 128 * (r / nb); q.n0 = 128 * (r % nb); q.dr = q.n0; return true; } r -= T_C;
    if (r < T_A) { const int nb = D / 128; q.W = a.w_attn_out; q.WT = (bf16_t*)(ws + WS_WA); q.K = DA; q.N = D; q.k0 = 128 * (r / nb); q.n0 = 128 * (r % nb); q.dr = q.n0; return true; } r -= T_A;
    if (r < T_O) { const int nb = D / 128; q.W = a.w_o; q.WT = (bf16_t*)(ws + WS_WO); q.K = D; q.N = D; q.k0 = 128 * (r / nb); q.n0 = 128 * (r % nb); q.dr = q.n0; return true; } r -= T_O;
    if (r < T_G) { const int nb = FF / 128; q.W = a.w_gate; q.WT = (bf16_t*)(ws + WS_WGU); q.gk = a.g_ffn; q.K = D; q.N = FF; q.k0 = 128 * (r / nb); q.n0 = 128 * (r % nb); q.dr = 2 * q.n0; return true; } r -= T_G;
    if (r < T_U) { const int nb = FF / 128; q.W = a.w_up; q.WT = (bf16_t*)(ws + WS_WGU); q.gk = a.g_ffn; q.K = D; q.N = FF; q.k0 = 128 * (r / nb); q.n0 = 128 * (r % nb); q.dr = 2 * q.n0 + 128; return true; } r -= T_U;
    if (r < T_D) { const int nb = D / 128; q.W = a.w_down; q.WT = (bf16_t*)(ws + WS_WD); q.K = FF; q.N = D; q.k0 = 128 * (r / nb); q.n0 = 128 * (r % nb); q.dr = q.n0; return true; }
    return false;
}
__device__ __forceinline__ void p0_load(const P0Item& q, int tid, f32x4 (&v)[8]) {
    const int c4 = tid & 31, kr = tid >> 5;
#pragma unroll
    for (int i = 0; i < 4; ++i) { const int k = q.k0 + 2 * (kr + 16 * i); const float* p = q.W + (size_t)k * q.N + q.n0 + 4 * c4;
        v[2 * i] = *(const f32x4*)p; v[2 * i + 1] = *(const f32x4*)(p + q.N);
        if (q.gk) { const float g0 = q.gk[k], g1 = q.gk[k + 1]; v[2 * i] = v[2 * i] * g0; v[2 * i + 1] = v[2 * i + 1] * g1; } }
}
__device__ __forceinline__ void p0_prologue(const Frame& F, const Args& a) {
    unsigned char* ws = a.ws;
    LAS unsigned char* T2 = F.lds;
    const int tid = F.tid;
    constexpr int NITEMS = (D / 128) * (NIN / 128) + 2 * (DC / 128) * (D / 128) + (D / 128) * (D / 128) + 2 * (D / 128) * (FF / 128) + (FF / 128) * (D / 128);
    { float* rs = (float*)((unsigned*)(ws + WS_CTL) + CW_ROWSS); for (int i = F.vcu * (NWAVES * 64) + tid; i < M; i += F.G * (NWAVES * 64)) rs[i] = 0.f; }
    P0Item q, qn; f32x4 v[8];
    int it = F.vcu; bool have = p0_decode(a, ws, it, q);
    if (have) p0_load(q, tid, v);
    while (have) {
        { const int c4 = tid & 31, kr = tid >> 5;
#pragma unroll
          for (int i = 0; i < 4; ++i) { u32x4 w; w.x = cvt_pk_bf16(v[2 * i][0], v[2 * i + 1][0]); w.y = cvt_pk_bf16(v[2 * i][1], v[2 * i + 1][1]); w.z = cvt_pk_bf16(v[2 * i][2], v[2 * i + 1][2]); w.w = cvt_pk_bf16(v[2 * i][3], v[2 * i + 1][3]);
              LAS unsigned char* tp = T2 + (kr + 16 * i) * P0_PITCH + c4 * 16; *(LAS u32x2*)tp = (u32x2){w.x, w.y}; *(LAS u32x2*)(tp + 8) = (u32x2){w.z, w.w}; } }
        __syncthreads();
        it += F.G; const bool hn = p0_decode(a, ws, it, qn);
        if (hn) p0_load(qn, tid, v);
        { const int k8 = tid & 15, nr = tid >> 4;
#pragma unroll
          for (int i = 0; i < 4; ++i) { const int n = nr + 32 * i; LAS const unsigned char* p = T2 + (4 * k8) * P0_PITCH + n * 4;
              u32x4 o; o.x = *(LAS const unsigned*)(p); o.y = *(LAS const unsigned*)(p + P0_PITCH); o.z = *(LAS const unsigned*)(p + 2 * P0_PITCH); o.w = *(LAS const unsigned*)(p + 3 * P0_PITCH);
              *(u32x4*)(q.WT + (size_t)(q.dr + n) * q.K + q.k0 + 8 * k8) = o; } }
        __syncthreads();
        q = qn; have = hn;
    }
    const int gw = F.vcu * NWAVES + F.wave, NGW = F.G * NWAVES;
    bf16_t* XN = (bf16_t*)(ws + WS_XN);
    for (int m = gw; m < M; m += NGW) {
        const float* xrow = (m < MP) ? a.x_prompt + (size_t)m * D : a.x_sample + (size_t)(m - MP) * D;
        const f32x4* xr = (const f32x4*)xrow + F.lane; const f32x4* gr = (const f32x4*)a.g_mix + F.lane;
        f32x4 xv[8]; float s = 0.f;
#pragma unroll
        for (int j = 0; j < 8; ++j) { xv[j] = xr[64 * j]; s += (xv[j][0] * xv[j][0] + xv[j][1] * xv[j][1]) + (xv[j][2] * xv[j][2] + xv[j][3] * xv[j][3]); }
        const float rstd = __builtin_amdgcn_rsqf(wave_sum(s) * (1.0f / D) + EPS);
        u32x2* o8 = (u32x2*)(XN + (size_t)m * D) + F.lane;
#pragma unroll
        for (int j = 0; j < 8; ++j) { const f32x4 g = gr[64 * j]; u32x2 w; w.x = cvt_pk_bf16(xv[j][0] * rstd * g[0], xv[j][1] * rstd * g[1]); w.y = cvt_pk_bf16(xv[j][2] * rstd * g[2], xv[j][3] * rstd * g[3]); o8[64 * j] = w; }
    }
}

constexpr int KIMG_STRIDE = 144, VT_STRIDE = 528;
constexpr int LDS_KIMG = 0, LDS_VT = 256 * KIMG_STRIDE, LDS_LUT = LDS_VT + 64 * VT_STRIDE, LDS_SINK = LDS_LUT + 4 * 128 * 4;
static_assert(LDS_SINK + 16 <= RING_BYTES, "attention LDS");

__device__ __forceinline__ void attn_group(LAS const unsigned char* lds, const int key0, const bf16x8 q0, const bf16x8 q1, const int dist0, const int min_krow, const int hl, bf16_t* outp, const int lane) {
    const int l15 = lane & 15, g = lane >> 4;
    f32x4 s[10];
    LAS const unsigned char* kp = lds + LDS_KIMG + (key0 + l15) * KIMG_STRIDE + g * 16;
#pragma unroll
    for (int T = 0; T < 10; ++T) {
        const bf16x8 k0f = *(LAS const bf16x8*)(kp + T * 16 * KIMG_STRIDE), k1f = *(LAS const bf16x8*)(kp + T * 16 * KIMG_STRIDE + 64);
        f32x4 a = (f32x4){0.f, 0.f, 0.f, 0.f};
        a = __builtin_amdgcn_mfma_f32_16x16x32_bf16(k0f, q0, a, 0, 0, 0);
        a = __builtin_amdgcn_mfma_f32_16x16x32_bf16(k1f, q1, a, 0, 0, 0);
        s[T] = a;
    }
    LAS const float* lut = (LAS const float*)(lds + LDS_LUT) + hl * 128;
    float mx = -INFINITY;
#pragma unroll
    for (int T = 0; T < 10; ++T)
#pragma unroll
        for (int r = 0; r < 4; ++r) {
            const int kk = 16 * T + 4 * g + r, dist = dist0 - kk;
            const bool valid = ((unsigned)dist < 128u) && (key0 + kk >= min_krow);
            const float v = valid ? s[T][r] + lut[dist & 127] : -INFINITY;
            s[T][r] = v; mx = fmaxf(mx, v);
        }
    mx = fmaxf(mx, __shfl_xor(mx, 16)); mx = fmaxf(mx, __shfl_xor(mx, 32));
    const float sink = ((LAS const float*)(lds + LDS_SINK))[hl];
    mx = fmaxf(mx, sink);
    float sum = 0.f;
#pragma unroll
    for (int T = 0; T < 10; ++T)
#pragma unroll
        for (int r = 0; r < 4; ++r) { const float p = __expf(s[T][r] - mx); s[T][r] = p; sum += p; }
    sum += __shfl_xor(sum, 16); sum += __shfl_xor(sum, 32);
    sum += __expf(sink - mx);
    const float inv = 1.0f / sum;
    bf16x8 pf[5];
#pragma unroll
    for (int P = 0; P < 5; ++P) pf[P] = __builtin_bit_cast(bf16x8, pg8::pack8(s[2 * P] * inv, s[2 * P + 1] * inv));
#pragma unroll
    for (int dt = 0; dt < 4; ++dt) {
        f32x4 o = (f32x4){0.f, 0.f, 0.f, 0.f};
        LAS const unsigned char* vp = lds + LDS_VT + (16 * dt + l15) * VT_STRIDE + (key0 + 4 * g) * 2;
#pragma unroll
        for (int P = 0; P < 5; ++P) {
            const u32x2 lo = *(LAS const u32x2*)(vp + 64 * P), hi = *(LAS const u32x2*)(vp + 64 * P + 32);
            const bf16x8 vf = __builtin_bit_cast(bf16x8, (u32x4){lo.x, lo.y, hi.x, hi.y});
            o = __builtin_amdgcn_mfma_f32_16x16x32_bf16(vf, pf[P], o, 0, 0, 0);
        }
        u32x2 w; w.x = cvt_pk_bf16(o[0], o[1]); w.y = cvt_pk_bf16(o[2], o[3]);
        *(u32x2*)(outp + 16 * dt + 4 * g) = w;
    }
}

__device__ __forceinline__ void p2_attention_conv(const Frame& F, const Args& a) {
    unsigned char* ws = a.ws;
    const bf16_t* Qb = (const bf16_t*)(ws + WS_Q); const bf16_t* Kb = (const bf16_t*)(ws + WS_K); const bf16_t* Vb = (const bf16_t*)(ws + WS_V);
    bf16_t* ATT = (bf16_t*)(ws + WS_ATT);
    LAS unsigned char* lds = F.lds;
    const int tid = F.tid, lane = F.lane, wave = F.wave, l15 = lane & 15, g = lane >> 4;
    for (int u = blockIdx.x; u < NBATCH * 16 * 4; u += F.G) {
        const int b = u >> 6, nb = (u >> 2) & 15, kvh = u & 3;
        __syncthreads();
        {
            const int hl = tid >> 7, dist = tid & 127;
            ((LAS float*)(lds + LDS_LUT))[tid] = a.rel_bias[T5_BUCKET[dist] * 16 + kvh * 4 + hl];
            if (tid < 4) ((LAS float*)(lds + LDS_SINK))[tid] = a.sinks[kvh * 4 + tid];
        }
#pragma unroll
        for (int i = 0; i < 4; ++i) {
            const int id = tid + 512 * i, r = id >> 3, c8 = id & 7, t = nb * WIN - WIN + r;
            u32x4 kv = (u32x4){0u, 0u, 0u, 0u}, vv = (u32x4){0u, 0u, 0u, 0u};
            if (t >= 0) { const size_t off = (size_t)(b * SEQ + t) * DKV + kvh * 64 + c8 * 8; kv = *(const u32x4*)(Kb + off); vv = *(const u32x4*)(Vb + off); }
            *(LAS u32x4*)(lds + LDS_KIMG + r * KIMG_STRIDE + c8 * 16) = kv;
            LAS unsigned char* vt = lds + LDS_VT + (c8 * 8) * VT_STRIDE + r * 2;
            *(LAS bf16_t*)(vt + 0 * VT_STRIDE) = (bf16_t)(vv.x & 0xffffu); *(LAS bf16_t*)(vt + 1 * VT_STRIDE) = (bf16_t)(vv.x >> 16);
            *(LAS bf16_t*)(vt + 2 * VT_STRIDE) = (bf16_t)(vv.y & 0xffffu); *(LAS bf16_t*)(vt + 3 * VT_STRIDE) = (bf16_t)(vv.y >> 16);
            *(LAS bf16_t*)(vt + 4 * VT_STRIDE) = (bf16_t)(vv.z & 0xffffu); *(LAS bf16_t*)(vt + 5 * VT_STRIDE) = (bf16_t)(vv.z >> 16);
            *(LAS bf16_t*)(vt + 6 * VT_STRIDE) = (bf16_t)(vv.w & 0xffffu); *(LAS bf16_t*)(vt + 7 * VT_STRIDE) = (bf16_t)(vv.w >> 16);
        }
        __syncthreads();
        const int hl = wave >> 1, head = kvh * 4 + hl;
#pragma unroll 1
        for (int i = 0; i < 4; ++i) {
            const int qg = (wave & 1) * 4 + i, qi0 = 16 * qg, key0 = 16 * (qg & ~1);
            const size_t row = (size_t)b * SEQ + nb * WIN + qi0 + l15;
            const bf16_t* qp = Qb + row * DA + head * 64 + 8 * g;
            const bf16x8 q0 = *(const bf16x8*)qp, q1 = *(const bf16x8*)(qp + 32);
            attn_group(lds, key0, q0, q1, qi0 + l15 + WIN - key0, nb == 0 ? WIN : 0, hl, ATT + row * DA + head * 64, lane);
        }
    }
    for (int u = blockIdx.x; u < DBATCH * 4; u += F.G) {
        const int b = u >> 2, kvh = u & 3;
        __syncthreads();
        {
            const int hl = tid >> 7, dist = tid & 127;
            ((LAS float*)(lds + LDS_LUT))[tid] = a.rel_bias[T5_BUCKET[dist] * 16 + kvh * 4 + hl];
            if (tid < 4) ((LAS float*)(lds + LDS_SINK))[tid] = a.sinks[kvh * 4 + tid];
        }
#pragma unroll
        for (int i = 0; i < 4; ++i) {
            const int id = tid + 512 * i, j = id >> 4, c4 = id & 15;
            const size_t off = ((size_t)(b * WIN + j) * 4 + kvh) * 64 + c4 * 4;
            const f32x4 kf = *(const f32x4*)(a.cache_k + off), vf = *(const f32x4*)(a.cache_v + off);
            if (j >= DSEQ) { const size_t oo = ((size_t)(b * WIN + j - DSEQ) * 4 + kvh) * 64 + c4 * 4; *(f32x4*)(a.out + OUT_KS + oo) = kf; *(f32x4*)(a.out + OUT_VS + oo) = vf; }
            u32x2 kw; kw.x = cvt_pk_bf16(kf[0], kf[1]); kw.y = cvt_pk_bf16(kf[2], kf[3]);
            *(LAS u32x2*)(lds + LDS_KIMG + j * KIMG_STRIDE + c4 * 8) = kw;
            const unsigned v01 = cvt_pk_bf16(vf[0], vf[1]), v23 = cvt_pk_bf16(vf[2], vf[3]);
            LAS unsigned char* vt = lds + LDS_VT + (c4 * 4) * VT_STRIDE + j * 2;
            *(LAS bf16_t*)(vt + 0 * VT_STRIDE) = (bf16_t)(v01 & 0xffffu); *(LAS bf16_t*)(vt + 1 * VT_STRIDE) = (bf16_t)(v01 >> 16);
            *(LAS bf16_t*)(vt + 2 * VT_STRIDE) = (bf16_t)(v23 & 0xffffu); *(LAS bf16_t*)(vt + 3 * VT_STRIDE) = (bf16_t)(v23 >> 16);
        }
        if (tid < 256) {
            const int r = WIN + (tid >> 3), c8 = tid & 7;
            u32x4 kv = (u32x4){0u, 0u, 0u, 0u}, vv = (u32x4){0u, 0u, 0u, 0u};
            if (r < WIN + DSEQ) { const size_t off = (size_t)(MP + b * DSEQ + (r - WIN)) * DKV + kvh * 64 + c8 * 8; kv = *(const u32x4*)(Kb + off); vv = *(const u32x4*)(Vb + off); }
            *(LAS u32x4*)(lds + LDS_KIMG + r * KIMG_STRIDE + c8 * 16) = kv;
            LAS unsigned char* vt = lds + LDS_VT + (c8 * 8) * VT_STRIDE + r * 2;
            *(LAS bf16_t*)(vt + 0 * VT_STRIDE) = (bf16_t)(vv.x & 0xffffu); *(LAS bf16_t*)(vt + 1 * VT_STRIDE) = (bf16_t)(vv.x >> 16);
            *(LAS bf16_t*)(vt + 2 * VT_STRIDE) = (bf16_t)(vv.y & 0xffffu); *(LAS bf16_t*)(vt + 3 * VT_STRIDE) = (bf16_t)(vv.y >> 16);
            *(LAS bf16_t*)(vt + 4 * VT_STRIDE) = (bf16_t)(vv.z & 0xffffu); *(LAS bf16_t*)(vt + 5 * VT_STRIDE) = (bf16_t)(vv.z >> 16);
            *(LAS bf16_t*)(vt + 6 * VT_STRIDE) = (bf16_t)(vv.w & 0xffffu); *(LAS bf16_t*)(vt + 7 * VT_STRIDE) = (bf16_t)(vv.w >> 16);
        }
        __syncthreads();
        if (wave < 2) {
            const int t = l15 & 7, hl = 2 * wave + (l15 >> 3), head = kvh * 4 + hl;
            const size_t row = (size_t)MP + b * DSEQ + t;
            const bf16_t* qp = Qb + row * DA + head * 64 + 8 * g;
            const bf16x8 q0 = *(const bf16x8*)qp, q1 = *(const bf16x8*)(qp + 32);
            attn_group(lds, 0, q0, q1, t + WIN, 0, hl, ATT + row * DA + head * 64, lane);
        }
    }
    __syncthreads();
    {
        const bf16_t* U = (const bf16_t*)(ws + WS_U); const bf16_t* Bg = (const bf16_t*)(ws + WS_BG); bf16_t* AC = (bf16_t*)(ws + WS_ACONV);
        for (int id = blockIdx.x * (NWAVES * 64) + tid; id < M * (DC / 8); id += F.G * (NWAVES * 64)) {
            const int row = id >> 7, c = (id & 127) * 8;
            f32x4 u2a, u2b, u1a, u1b, u0a, u0b, ba, bb;
            pg8::unpack8(*(const u32x4*)(U + (size_t)row * DC + c), u0a, u0b);
            pg8::unpack8(*(const u32x4*)(Bg + (size_t)row * DC + c), ba, bb);
            int t; const float* st = nullptr;
            if (row < MP) t = row & (SEQ - 1); else { const int s = row - MP; t = s & 7; st = a.state_conv + (size_t)(s >> 3) * 2 * DC + c; }
            if (t >= 1) pg8::unpack8(*(const u32x4*)(U + (size_t)(row - 1) * DC + c), u1a, u1b);
            else if (st) { u1a = *(const f32x4*)(st + DC); u1b = *(const f32x4*)(st + DC + 4); }
            else { u1a = (f32x4){0.f, 0.f, 0.f, 0.f}; u1b = u1a; }
            if (t >= 2) pg8::unpack8(*(const u32x4*)(U + (size_t)(row - 2) * DC + c), u2a, u2b);
            else if (st) { const float* p = st + (t == 1 ? DC : 0); u2a = *(const f32x4*)p; u2b = *(const f32x4*)(p + 4); }
            else { u2a = (f32x4){0.f, 0.f, 0.f, 0.f}; u2b = u2a; }
            const f32x4 w0a = *(const f32x4*)(a.w_conv + c), w0b = *(const f32x4*)(a.w_conv + c + 4), w1a = *(const f32x4*)(a.w_conv + DC + c), w1b = *(const f32x4*)(a.w_conv + DC + c + 4),
                        w2a = *(const f32x4*)(a.w_conv + 2 * DC + c), w2b = *(const f32x4*)(a.w_conv + 2 * DC + c + 4);
            const f32x4 oa = ba * (w0a * u2a + w1a * u1a + w2a * u0a), ob = bb * (w0b * u2b + w1b * u1b + w2b * u0b);
            *(u32x4*)(AC + (size_t)row * DC + c) = pg8::pack8(oa, ob);
        }
    }
}

__device__ __forceinline__ void p7_final_norm(const Frame& F, const Args& a) {
    const int gw = F.vcu * NWAVES + F.wave, NGW = F.G * NWAVES;
    for (int m = gw; m < M; m += NGW) {
        f32x4* xr = (f32x4*)(a.out + OUT_Y + (size_t)m * D) + F.lane; const f32x4* gr = (const f32x4*)a.g_final + F.lane;
        f32x4 v[8]; float s = 0.f;
#pragma unroll
        for (int j = 0; j < 8; ++j) { v[j] = xr[64 * j]; s += (v[j][0] * v[j][0] + v[j][1] * v[j][1]) + (v[j][2] * v[j][2] + v[j][3] * v[j][3]); }
        const float rstd = __builtin_amdgcn_rsqf(wave_sum(s) * (1.0f / D) + EPS);
#pragma unroll
        for (int j = 0; j < 8; ++j) xr[64 * j] = v[j] * rstd * gr[64 * j];
    }
}

constexpr int N_PHASES = 8;
__global__ void __launch_bounds__(NWAVES * 64, 2) fwd_kernel(Args args) {
    extern __shared__ __attribute__((aligned(16))) unsigned char lds_raw[];
    Frame F;
    F.lds = (LAS unsigned char*)lds_raw;
    F.tid = threadIdx.x; F.lane = F.tid & 63; F.wave = __builtin_amdgcn_readfirstlane(F.tid >> 6);
    F.G = gridDim.x; { const int bx = blockIdx.x; F.vcu = (F.G % 8 == 0) ? (bx % 8) * (F.G / 8) + bx / 8 : bx; }
    unsigned char* ws = args.ws;
    unsigned* ctl = (unsigned*)(ws + WS_CTL);
    volatile LAS unsigned* MISC = (volatile LAS unsigned*)(F.lds + MISC_OFF);
    for (int u = F.tid; u < (LDS_BYTES - LDSCTL_OFF) / 4; u += NWAVES * 64) ((LAS unsigned*)(F.lds + LDSCTL_OFF))[u] = 0u;
    __syncthreads();
    XcdBarrier bar; bar.bar = ctl + CW_BAR; bar.x = 0; bar.st = nullptr;
    if (MK_N_LAUNCHES == 1) bar = xcd_barrier_post(ctl + CW_BAR, MISC + 8);
    const int lo = args.ph_lo, hi = args.ph_hi;
#define IN(k) (lo <= (k) && (k) < hi)
#define SEAM(k) do { if (IN(k) && IN((k) + 1)) xcd_barrier(bar); } while (0)
    float* rowss = (float*)(ctl + CW_ROWSS);

#ifndef REP0
#define REP0 1
#endif
#ifndef REP2
#define REP2 1
#endif
#ifndef REP5
#define REP5 1
#endif
    if (IN(0)) { for (int rep = 0; rep < REP0; ++rep) { p0_prologue(F, args); SEAM(0); } }
    if (IN(1)) {
        pg8::SchedG S; S.o.init(M / 256, NIN / 256, F.G, (int)blockIdx.x); S.A = (const char*)(ws + WS_XN); S.B = (const char*)(ws + WS_WIN); S.tstep = (size_t)256 * D * 2;
        pg8::EpiIn E{(bf16_t*)(ws + WS_BG), (bf16_t*)(ws + WS_U), (bf16_t*)(ws + WS_Q), (bf16_t*)(ws + WS_K), (bf16_t*)(ws + WS_V), (bf16_t*)(ws + WS_SG1), (bf16_t*)(ws + WS_SG2), args.out};
        pg8::gemm_phase(F.lds, D, S, E);
        SEAM(1);
    }
    if (IN(2)) { for (int rep = 0; rep < REP2; ++rep) { p2_attention_conv(F, args); SEAM(2); } }
    if (IN(3)) {
        pg8::SchedMix S; S.o.init(M / 256, D / 256, F.G, (int)blockIdx.x);
        S.A0 = (const char*)(ws + WS_ACONV); S.A1 = (const char*)(ws + WS_ATT); S.B0 = (const char*)(ws + WS_WC); S.B1 = (const char*)(ws + WS_WA); S.tstep = (size_t)256 * DC * 2;
        pg8::EpiMix E{(bf16_t*)(ws + WS_SG1), (bf16_t*)(ws + WS_SG2)};
        pg8::gemm_phase(F.lds, DC, S, E);
        SEAM(3);
    }
    if (IN(4)) {
        pg8::SchedG S; S.o.init(M / 256, D / 256, F.G, (int)blockIdx.x); S.A = (const char*)(ws + WS_SG1); S.B = (const char*)(ws + WS_WO); S.tstep = (size_t)256 * D * 2;
        pg8::EpiWo E{args.x_prompt, args.x_sample, args.out + OUT_Y, (bf16_t*)(ws + WS_SG2), rowss};
        pg8::gemm_phase(F.lds, D, S, E);
        SEAM(4);
    }
    if (IN(5)) {
        pg8::SchedG S; S.o.init(M / 256, NGU / 256, F.G, (int)blockIdx.x); S.A = (const char*)(ws + WS_SG2); S.B = (const char*)(ws + WS_WGU); S.tstep = (size_t)256 * D * 2;
        pg8::EpiGU E{(bf16_t*)(ws + WS_ACT), rowss};
        for (int rep = 0; rep < REP5; ++rep) { pg8::gemm_phase(F.lds, D, S, E); SEAM(5); }
    }
    if (IN(6)) {
        pg8::SchedG S; S.o.init(M / 256, D / 256, F.G, (int)blockIdx.x); S.A = (const char*)(ws + WS_ACT); S.B = (const char*)(ws + WS_WD); S.tstep = (size_t)256 * FF * 2;
        pg8::EpiDown E{args.out + OUT_Y};
        pg8::gemm_phase(F.lds, FF, S, E);
        SEAM(6);
    }
    if (IN(7)) { p7_final_norm(F, args); }
#undef IN
#undef SEAM
}

extern "C" void kernel_launch(void* const* d_in, const int* in_sizes, int n_in, void* d_out, int out_size, void* d_ws, size_t ws_size, hipStream_t stream) {
    static int grid = 0;
    if (grid == 0) {
        if (n_in != 18 || (size_t)out_size != OUT_END || ws_size < WS_END) { fprintf(stderr, "kernel_launch: unexpected shapes: n_in %d out %d ws %zu (need %zu)\n", n_in, out_size, ws_size, (size_t)WS_END); grid = -1; return; }
        int dev = 0, cus = 0, per_cu = 0;
        if (hipGetDevice(&dev) != hipSuccess || hipDeviceGetAttribute(&cus, hipDeviceAttributeMultiprocessorCount, dev) != hipSuccess) { grid = -1; return; }
        if (hipFuncSetAttribute((const void*)fwd_kernel, hipFuncAttributeMaxDynamicSharedMemorySize, LDS_BYTES) != hipSuccess) { fprintf(stderr, "kernel_launch: hipFuncSetAttribute failed\n"); grid = -1; return; }
        if (hipOccupancyMaxActiveBlocksPerMultiprocessor(&per_cu, (const void*)fwd_kernel, NWAVES * 64, LDS_BYTES) != hipSuccess || per_cu < 1) { fprintf(stderr, "kernel_launch: occupancy query says %d blocks per CU\n", per_cu); per_cu = 1; }
        (void)hipGetLastError();
        grid = cus;
    }
    if (grid < 0) return;
    (void)hipMemsetAsync((char*)d_ws + WS_CTL, 0, CTL_ZERO_BYTES, stream);
    Args a{};
    a.x_prompt = (const float*)d_in[0]; a.x_sample = (const float*)d_in[1]; a.cache_k = (const float*)d_in[2]; a.cache_v = (const float*)d_in[3]; a.state_conv = (const float*)d_in[4];
    a.rel_bias = (const float*)d_in[5]; a.w_in = (const float*)d_in[6]; a.w_conv = (const float*)d_in[7]; a.w_conv_out = (const float*)d_in[8]; a.sinks = (const float*)d_in[9];
    a.w_attn_out = (const float*)d_in[10]; a.w_o = (const float*)d_in[11]; a.g_mix = (const float*)d_in[12]; a.g_ffn = (const float*)d_in[13]; a.w_gate = (const float*)d_in[14];
    a.w_up = (const float*)d_in[15]; a.w_down = (const float*)d_in[16]; a.g_final = (const float*)d_in[17];
    a.out = (float*)d_out; a.ws = (unsigned char*)d_ws;
    if (MK_N_LAUNCHES == 1) {
        a.ph_lo = 0; a.ph_hi = N_PHASES;
        void* kargs[] = {&a};
        hipError_t e = hipLaunchCooperativeKernel((const void*)fwd_kernel, dim3(grid), dim3(NWAVES * 64), kargs, LDS_BYTES, stream);
        if (e != hipSuccess) fprintf(stderr, "kernel_launch: cooperative launch failed: %s (grid %d)\n", hipGetErrorString(e), grid);
    } else {
        for (int p = 0; p < N_PHASES; ++p) {
            a.ph_lo = p; a.ph_hi = p + 1;
            hipLaunchKernelGGL(fwd_kernel, dim3(grid), dim3(NWAVES * 64), LDS_BYTES, stream, a);
        }
    }
}
```

```cpp
#include <hip/hip_runtime.h>
#include <cstdio>
#include <cstdint>

#ifndef MK_N_LAUNCHES
#define MK_N_LAUNCHES 1
#endif

#define LAS __attribute__((address_space(3)))
#define GAS __attribute__((address_space(1)))
typedef unsigned short bf16_t;
typedef short bf16x8 __attribute__((ext_vector_type(8)));
typedef float f32x4 __attribute__((ext_vector_type(4)));
typedef unsigned u32x4 __attribute__((ext_vector_type(4)));
typedef unsigned u32x2 __attribute__((ext_vector_type(2)));

constexpr int D = 2048, DC = 1024, DA = 1024, DKV = 256, NIN = 8704, FF = 5632, NGU = 2 * FF;
constexpr int MP = 8192, MS = 1024, M = MP + MS;
constexpr int SEQ = 2048, NBATCH = 4, DBATCH = 128, DSEQ = 8, WIN = 128;
constexpr float EPS = 1e-6f;
constexpr size_t OUT_Y = 0, OUT_KP = (size_t)M * D, OUT_VP = OUT_KP + 131072, OUT_CP = OUT_VP + 131072, OUT_KS = OUT_CP + 8192,
                 OUT_VS = OUT_KS + 4194304, OUT_CS = OUT_VS + 4194304, OUT_END = OUT_CS + 262144;
constexpr size_t MiB = 1u << 20;
constexpr size_t WS_CTL = 0, CTL_ZERO_BYTES = 1 * MiB;
constexpr size_t WS_WIN = 1 * MiB, WS_WC = 35 * MiB, WS_WA = 39 * MiB, WS_WO = 43 * MiB, WS_WGU = 51 * MiB, WS_WD = 95 * MiB;
constexpr size_t WS_XN = 117 * MiB, WS_ACONV = WS_XN, WS_ATT = WS_XN + 18 * MiB;
constexpr size_t WS_BG = 153 * MiB, WS_U = 171 * MiB, WS_Q = 189 * MiB, WS_K = 207 * MiB, WS_V = WS_K + (size_t)M * DKV * 2;
constexpr size_t WS_SG1 = 216 * MiB, WS_SG2 = 252 * MiB;
constexpr size_t WS_ACT1 = WS_BG;
constexpr size_t WS_ACT2 = 288 * MiB;
constexpr size_t WS_END = 288 * MiB + (size_t)14 * 256 * FF * 2;
static_assert(WS_V + (size_t)M * DKV * 2 == 216 * MiB && WS_ACT1 + (size_t)22 * 256 * FF * 2 <= 216 * MiB, "ws map");
constexpr int CW_BAR = 4096;
constexpr int CW_ROWSS = 32768;
constexpr int CW_CNT = 16384;
constexpr int CW_TMO = 8;

constexpr int RING_BYTES = 131072;
constexpr int LDSCTL_OFF = RING_BYTES, MISC_OFF = LDSCTL_OFF + 320;
constexpr int LDS_BYTES = 147456;
constexpr int NWAVES = 8;

#define LDS_WAIT() asm volatile("s_waitcnt lgkmcnt(0)" ::: "memory")
#define VM_WAIT() asm volatile("s_waitcnt vmcnt(0)" ::: "memory")
typedef float f32x2_t __attribute__((ext_vector_type(2))); typedef __bf16 bf16x2_t __attribute__((ext_vector_type(2)));
__device__ __forceinline__ unsigned cvt_pk_bf16(float lo, float hi) { const f32x2_t v = {lo, hi}; const bf16x2_t b = __builtin_convertvector(v, bf16x2_t); return __builtin_bit_cast(unsigned, b); }
__device__ __forceinline__ float bf_lo(unsigned w) { return __builtin_bit_cast(float, w << 16); }
__device__ __forceinline__ float bf_hi(unsigned w) { return __builtin_bit_cast(float, w & 0xffff0000u); }
__device__ __forceinline__ float fsigmoid(float x) { return __builtin_amdgcn_rcpf(1.0f + __expf(-x)); }
__device__ __forceinline__ float wave_sum(float v) {
#pragma unroll
    for (int o = 1; o < 64; o <<= 1) v += __shfl_xor(v, o);
    return v;
}

namespace pg8 {
constexpr int BM = 256, BK = 64, HALF = 128, HTB = HALF * BK * 2, STAGE_BYTES = 8 * HTB, NXCD = 8, WGM = 8;
__host__ __device__ __forceinline__ int lds_byte(int r, int c) { const int st = (r >> 4) * 2 + (c >> 5), rr = r & 15, cc = c & 31, ob = rr * 64 + cc * 2; return st * 1024 + (ob ^ (((ob >> 9) & 1) << 5)); }
__host__ __device__ __forceinline__ void stage_rc(int b, int& R, int& C) { const int st = b / 1024, sb = b % 1024, swz = sb ^ (((sb >> 9) & 1) << 5); R = (st >> 1) * 16 + swz / 64; C = (st & 1) * 32 + (swz % 64) / 2; }
__host__ __device__ __forceinline__ int perm32(int rho) { const int n = rho >> 4, i = rho & 15; return 8 * (i >> 2) + 4 * n + (i & 3); }

struct Unit { int pm, pn, aux; };
struct OrderMap {
    int nM, nN, nwg, G, c;
    __device__ __forceinline__ void init(int nM_, int nN_, int G_, int c_) { nM = nM_; nN = nN_; nwg = nM * nN; G = G_; c = c_; }
    __device__ __forceinline__ bool tile(int i, int& pm, int& pn) const {
        const long L = (long)i * G + c; if (L >= nwg) return false;
        int wgid = (int)L; { const int q = nwg / NXCD, r = nwg % NXCD, xcd = wgid % NXCD, off = wgid / NXCD; wgid = (xcd < r ? xcd * (q + 1) : r * (q + 1) + (xcd - r) * q) + off; }
        const int nig = WGM * nN, gid = wgid / nig, fm = gid * WGM, gsz = (nM - fm) < WGM ? (nM - fm) : WGM;
        pm = fm + ((wgid % nig) % gsz); pn = (wgid % nig) / gsz; return true;
    }
};
struct SchedG {
    OrderMap o; const char* A; const char* B; size_t tstep;
    __device__ __forceinline__ bool next(int i, Unit& u) const { u.aux = 0; return o.tile(i, u.pm, u.pn); }
    __device__ __forceinline__ const char* a_ptr(const Unit& u) const { return A + (size_t)u.pm * tstep; }
    __device__ __forceinline__ const char* b_ptr(const Unit& u) const { return B + (size_t)u.pn * tstep; }
};
struct SchedMix {
    OrderMap o; const char *A0, *A1, *B0, *B1; size_t tstep;
    __device__ __forceinline__ bool next(int i, Unit& u) const { u.aux = i & 1; return o.tile(i >> 1, u.pm, u.pn); }
    __device__ __forceinline__ const char* a_ptr(const Unit& u) const { return (u.aux ? A1 : A0) + (size_t)u.pm * tstep; }
    __device__ __forceinline__ const char* b_ptr(const Unit& u) const { return (u.aux ? B1 : B0) + (size_t)u.pn * tstep; }
};

template <class Epi, class Sched>
__device__ __forceinline__ void gemm_phase(LAS unsigned char* lds, const int K, const Sched& S, const Epi& E) {
    const int tid = threadIdx.x, wid = __builtin_amdgcn_readfirstlane(tid >> 6), lane = tid & 63, wr = wid >> 2, wc = wid & 3, fr = lane & 15, fq = lane >> 4;
    const int nt = K / BK;
    unsigned voffA[2], voffB[2];
#pragma unroll
    for (int i = 0; i < 2; ++i) { int R, C; stage_rc(tid * 16 + i * 8192, R, C); const int Rb = (R & ~31) + perm32(R & 31);
        voffA[i] = (unsigned)(R * K + C) * 2u; voffB[i] = (unsigned)(Rb * K + C) * 2u; }
    const size_t kstep = (size_t)(BK * 2);
    const size_t hstep = (size_t)HALF * K * 2;
    const unsigned ldsw = (unsigned)wid * 1024u;
    const int aoff = lds_byte(wr * 64 + fr, fq * 8), boff = lds_byte(wc * 32 + fr, fq * 8);
#define PG8_SA(b, h) (((b) * 2 + (h)) * HTB)
#define PG8_SB(b, h) ((4 + (b) * 2 + (h)) * HTB)
#define PG8_STAGE(bufoff, gbase, voff) do { _Pragma("unroll") for (int _i = 0; _i < 2; ++_i) \
        __builtin_amdgcn_global_load_lds((const unsigned*)((const char*)(gbase) + (voff)[_i]), (LAS unsigned*)(lds + (bufoff) + ldsw + _i * 8192), 16, 0, 0); } while (0)
#define PG8_LDA(dst, b, h) do { _Pragma("unroll") for (int m = 0; m < 4; ++m) _Pragma("unroll") for (int k = 0; k < 2; ++k) dst[m][k] = *(const LAS bf16x8*)(lds + PG8_SA(b, h) + aoff + m * 2048 + k * 1024); } while (0)
#define PG8_LDB(dst, b, h) do { _Pragma("unroll") for (int n = 0; n < 2; ++n) _Pragma("unroll") for (int k = 0; k < 2; ++k) dst[n][k] = *(const LAS bf16x8*)(lds + PG8_SB(b, h) + boff + n * 2048 + k * 1024); } while (0)
#define PG8_MMA(ai, bj, At, Bt) do { __builtin_amdgcn_s_setprio(1); _Pragma("unroll") for (int m = 0; m < 4; ++m) _Pragma("unroll") for (int n = 0; n < 2; ++n) _Pragma("unroll") for (int k = 0; k < 2; ++k) \
        acc[ai][bj][m][n] = __builtin_amdgcn_mfma_f32_16x16x32_bf16(Bt[n][k], At[m][k], acc[ai][bj][m][n], 0, 0, 0); __builtin_amdgcn_s_setprio(0); } while (0)
#define PG8_WAIT_V(n) asm volatile("s_waitcnt vmcnt(" #n ")" ::: "memory")
#define PG8_WAIT_L(n) asm volatile("s_waitcnt lgkmcnt(" #n ")" ::: "memory")
#define PG8_BAR __builtin_amdgcn_s_barrier()
#define PG8_SCHED __builtin_amdgcn_sched_barrier(0)
    Unit cur, nxt; int ui = 0;
    if (!S.next(0, cur)) return;
    f32x4 acc[2][2][4][2];
#pragma unroll
    for (int a = 0; a < 2; ++a)
#pragma unroll
        for (int b = 0; b < 2; ++b)
#pragma unroll
            for (int m = 0; m < 4; ++m)
#pragma unroll
                for (int n = 0; n < 2; ++n) acc[a][b][m][n] = (f32x4){0.f, 0.f, 0.f, 0.f};
    bf16x8 At[4][2], B0[2][2], B1[2][2];
    const char* cA = S.a_ptr(cur); const char* cB = S.b_ptr(cur);
    PG8_STAGE(PG8_SB(0, 0), cB, voffB); PG8_STAGE(PG8_SB(0, 1), cB + hstep, voffB); PG8_STAGE(PG8_SA(0, 0), cA, voffA); PG8_STAGE(PG8_SA(0, 1), cA + hstep, voffA);
    if (wr == 1) PG8_BAR;
    PG8_WAIT_V(2); PG8_BAR;
    PG8_STAGE(PG8_SB(1, 0), cB + kstep, voffB); PG8_STAGE(PG8_SA(1, 0), cA + kstep, voffA); PG8_STAGE(PG8_SB(1, 1), cB + hstep + kstep, voffB);
    PG8_WAIT_V(6); PG8_BAR;
    for (;;) {
        const bool has_next = S.next(ui + 1, nxt);
        const char* nA = has_next ? S.a_ptr(nxt) : cA; const char* nB = has_next ? S.b_ptr(nxt) : cB;
        for (int t = 0; t < nt; t += 2) {
            const bool last = (t == nt - 2);
            const char* a1 = cA + (size_t)(t + 1) * kstep;
            const char* a2 = last ? nA : cA + (size_t)(t + 2) * kstep; const char* b2 = last ? nB : cB + (size_t)(t + 2) * kstep;
            const char* a3 = a2 + kstep; const char* b3 = b2 + kstep;
            PG8_LDB(B0, 0, 0); PG8_LDB(B1, 0, 1); PG8_SCHED; PG8_LDA(At, 0, 0); PG8_STAGE(PG8_SA(1, 1), a1 + hstep, voffA);
            PG8_WAIT_V(8); PG8_WAIT_L(0); PG8_BAR; PG8_MMA(0, 0, At, B0); PG8_MMA(0, 1, At, B1); PG8_BAR; PG8_SCHED;
            PG8_LDA(At, 0, 1); PG8_STAGE(PG8_SB(0, 0), b2, voffB); PG8_STAGE(PG8_SB(0, 1), b2 + hstep, voffB); PG8_STAGE(PG8_SA(0, 0), a2, voffA);
            PG8_WAIT_V(8); PG8_WAIT_L(0); PG8_BAR; PG8_MMA(1, 0, At, B0); PG8_MMA(1, 1, At, B1); PG8_BAR; PG8_SCHED;
            PG8_LDB(B0, 1, 0); PG8_LDB(B1, 1, 1); PG8_SCHED; PG8_LDA(At, 1, 0); PG8_STAGE(PG8_SA(0, 1), a2 + hstep, voffA);
            PG8_WAIT_V(8); PG8_WAIT_L(0); PG8_BAR; PG8_MMA(0, 0, At, B0); PG8_MMA(0, 1, At, B1); PG8_BAR; PG8_SCHED;
            PG8_LDA(At, 1, 1); PG8_STAGE(PG8_SB(1, 0), b3, voffB); PG8_STAGE(PG8_SB(1, 1), b3 + hstep, voffB); PG8_STAGE(PG8_SA(1, 0), a3, voffA);
            PG8_WAIT_V(8); PG8_WAIT_L(0); PG8_BAR; PG8_MMA(1, 0, At, B0); PG8_MMA(1, 1, At, B1); PG8_BAR; PG8_SCHED;
        }
        if (wr == 0) PG8_BAR;
        E(acc, cur, wr, wc, fr, fq);
        if (!has_next) break;
        if (!E.keep(cur)) {
#pragma unroll
            for (int a = 0; a < 2; ++a)
#pragma unroll
                for (int b = 0; b < 2; ++b)
#pragma unroll
                    for (int m = 0; m < 4; ++m)
#pragma unroll
                        for (int n = 0; n < 2; ++n) acc[a][b][m][n] = (f32x4){0.f, 0.f, 0.f, 0.f};
        }
        cur = nxt; cA = nA; cB = nB; ++ui;
        if (wr == 1) PG8_BAR;
    }
    PG8_WAIT_V(0);
    PG8_BAR;
#undef PG8_SA
#undef PG8_SB
#undef PG8_STAGE
#undef PG8_LDA
#undef PG8_LDB
#undef PG8_MMA
#undef PG8_WAIT_V
#undef PG8_WAIT_L
#undef PG8_BAR
#undef PG8_SCHED
}

__device__ __forceinline__ u32x4 pack8(const f32x4 v0, const f32x4 v1) { u32x4 w; w.x = cvt_pk_bf16(v0[0], v0[1]); w.y = cvt_pk_bf16(v0[2], v0[3]); w.z = cvt_pk_bf16(v1[0], v1[1]); w.w = cvt_pk_bf16(v1[2], v1[3]); return w; }
__device__ __forceinline__ void unpack8(const u32x4 w, f32x4& v0, f32x4& v1) { v0 = (f32x4){bf_lo(w.x), bf_hi(w.x), bf_lo(w.y), bf_hi(w.y)}; v1 = (f32x4){bf_lo(w.z), bf_hi(w.z), bf_lo(w.w), bf_hi(w.w)}; }

struct EpiIn {
    bf16_t *Bg, *U, *Q, *Kb, *Vb, *SG1, *SG2; float* out;
    __device__ __forceinline__ bool keep(const Unit&) const { return false; }
    __device__ __forceinline__ void operator()(f32x4 (&acc)[2][2][4][2], const Unit& u, int wr, int wc, int fr, int fq) const {
        const int pn = u.pn, row0 = u.pm * BM + wr * 64 + fr, cl = wc * 32 + 8 * fq;
        if (pn >= 4 && pn < 12) {
            const int ch = 128 * (pn - 4) + cl;
#pragma unroll
            for (int ai = 0; ai < 2; ++ai)
#pragma unroll
                for (int m = 0; m < 4; ++m) {
                    const int row = row0 + ai * HALF + m * 16;
                    const f32x4 u0 = acc[ai][0][m][0] * acc[ai][1][m][0], u1 = acc[ai][0][m][1] * acc[ai][1][m][1];
                    *(u32x4*)(U + (size_t)row * DC + ch) = pack8(u0, u1);
                    bool st; size_t idx;
                    if (row < MP) { const int t = row & (SEQ - 1); st = t >= SEQ - 2; idx = OUT_CP + (size_t)((row >> 11) * 2 + (t - (SEQ - 2))) * DC + ch; }
                    else { const int s = row - MP, t = s & 7; st = t >= 6; idx = OUT_CS + (size_t)((s >> 3) * 2 + (t - 6)) * DC + ch; }
                    if (st) { *(f32x4*)(out + idx) = u0; *(f32x4*)(out + idx + 4) = u1; }
                }
            return;
        }
        bf16_t* dst; int ld, col0; float sc = 1.f; bool sig = false; int side = 0;
        if (pn < 4) { dst = Bg; ld = DC; col0 = 256 * pn; }
        else if (pn < 16) { dst = Q; ld = DA; col0 = 256 * (pn - 12); sc = 0.125f; }
        else if (pn == 16) { dst = Kb; ld = DKV; col0 = 0; side = 1; }
        else if (pn == 17) { dst = Vb; ld = DKV; col0 = 0; side = 2; }
        else if (pn < 26) { dst = SG1; ld = D; col0 = 256 * (pn - 18); sig = true; }
        else { dst = SG2; ld = D; col0 = 256 * (pn - 26); sig = true; }
#pragma unroll
        for (int ai = 0; ai < 2; ++ai)
#pragma unroll
            for (int m = 0; m < 4; ++m) {
                const int row = row0 + ai * HALF + m * 16;
                bool st = false; size_t sidx = 0;
                if (side) {
                    if (row < MP) { const int t = row & (SEQ - 1); st = t >= SEQ - WIN; sidx = (side == 1 ? OUT_KP : OUT_VP) + (size_t)((row >> 11) * WIN + (t - (SEQ - WIN))) * DKV; }
                    else { const int s = row - MP; st = true; sidx = (side == 1 ? OUT_KS : OUT_VS) + (size_t)((s >> 3) * WIN + (WIN - DSEQ) + (s & 7)) * DKV; }
                }
#pragma unroll
                for (int bj = 0; bj < 2; ++bj) {
                    f32x4 v0 = acc[ai][bj][m][0], v1 = acc[ai][bj][m][1];
                    if (st) { *(f32x4*)(out + sidx + bj * HALF + cl) = v0; *(f32x4*)(out + sidx + bj * HALF + cl + 4) = v1; }
                    if (sig) {
#pragma unroll
                        for (int j = 0; j < 4; ++j) { v0[j] = fsigmoid(v0[j]); v1[j] = fsigmoid(v1[j]); }
                    } else { v0 = v0 * sc; v1 = v1 * sc; }
                    *(u32x4*)(dst + (size_t)row * ld + col0 + bj * HALF + cl) = pack8(v0, v1);
                }
            }
    }
};
enum { K_MIX0 = 0, K_MIX1 = 1, K_WO = 2, K_GU = 3, K_DN0 = 4, K_DN1 = 5 };
struct SU { int kind, pm, pn; };
struct SParams { const char* a; const char* b; int nt; unsigned pitch2; unsigned* dep; unsigned need; unsigned* pub; };
struct StreamCtx {
    const char *ACONV, *ATT, *WC, *WA, *MERGED, *WO, *HB, *WGU, *ACT1, *ACT2, *WD; unsigned* cnt;
};
constexpr int ACT_SPLIT_PM = 22;
constexpr int CNT_MIX = 0, CNT_WO = 1, CNT_GU = 2;
struct StreamSched {
    int x, r; StreamCtx c;
    __device__ __forceinline__ static void tile8(int x, int t, int& pm, int& pn) {
        if (t < 32) { pm = x + 8 * (t & 3); pn = t >> 2; } else { const int s = 4 * x + (t - 32); pm = 32 + (s >> 3); pn = s & 7; } }
    __device__ __forceinline__ bool next(int k, SU& u) const {
        const int nmix = (r < 4) ? 2 : 1;
        int e, aux = 0;
        if (k < 2 * nmix) { e = r + 32 * (k >> 1); aux = k & 1; } else e = r + 32 * (k - nmix);
        if (e >= 342) return false;
        if (e < 36) { u.kind = aux ? K_MIX1 : K_MIX0; tile8(x, e, u.pm, u.pn); }
        else if (e < 72) { u.kind = K_WO; tile8(x, e - 36, u.pm, u.pn); }
        else if (e < 270) { const int q = e - 72; u.kind = K_GU;
            if (q < 160) { const int w = q & 31; u.pm = x + 8 * (w & 3); u.pn = 8 * (q >> 5) + (w >> 2); }
            else if (q < 176) { const int w = q - 160; u.pm = x + 8 * (w & 3); u.pn = 40 + (w >> 2); }
            else { const int sidx = 22 * x + (q - 176); u.pm = 32 + sidx / 44; u.pn = sidx % 44; } }
        else { const int q = e - 270; u.kind = (q & 1) ? K_DN1 : K_DN0; tile8(x, q >> 1, u.pm, u.pn); }
        return true;
    }
    __device__ __forceinline__ void params(const SU& u, SParams& p) const {
        p.dep = nullptr; p.need = 0; p.pub = nullptr;
        switch (u.kind) {
        case K_MIX0: p.a = c.ACONV + (size_t)u.pm * (256 * DC * 2); p.b = c.WC + (size_t)u.pn * (256 * DC * 2); p.nt = DC / 64; p.pitch2 = DC * 2; break;
        case K_MIX1: p.a = c.ATT + (size_t)u.pm * (256 * DA * 2); p.b = c.WA + (size_t)u.pn * (256 * DA * 2); p.nt = DA / 64; p.pitch2 = DA * 2; p.pub = c.cnt + (CNT_MIX * 36 + u.pm) * 64; break;
        case K_WO: p.a = c.MERGED + (size_t)u.pm * (256 * D * 2); p.b = c.WO + (size_t)u.pn * (256 * D * 2); p.nt = D / 64; p.pitch2 = D * 2;
            p.dep = c.cnt + (CNT_MIX * 36 + u.pm) * 64; p.need = 64; p.pub = c.cnt + (CNT_WO * 36 + u.pm) * 64; break;
        case K_GU: p.a = c.HB + (size_t)u.pm * (256 * D * 2); p.b = c.WGU + (size_t)u.pn * (256 * D * 2); p.nt = D / 64; p.pitch2 = D * 2;
            p.dep = c.cnt + (CNT_WO * 36 + u.pm) * 64; p.need = 64; p.pub = c.cnt + (CNT_GU * 36 + u.pm) * 64; break;
        default: { const int h = (u.kind == K_DN1);
            p.a = (u.pm < ACT_SPLIT_PM ? c.ACT1 + (size_t)u.pm * (256 * FF * 2) : c.ACT2 + (size_t)(u.pm - ACT_SPLIT_PM) * (256 * FF * 2)) + h * (FF);
            p.b = c.WD + (size_t)u.pn * (256 * FF * 2) + h * (FF); p.nt = FF / 128; p.pitch2 = FF * 2;
            p.dep = c.cnt + (CNT_GU * 36 + u.pm) * 64; p.need = 352; } break;
        }
    }
};
__device__ __forceinline__ bool stream_poll_once(unsigned* dep, unsigned need) {
    const bool ok = (unsigned)__builtin_amdgcn_readfirstlane(__hip_atomic_load(dep, __ATOMIC_RELAXED, __HIP_MEMORY_SCOPE_AGENT)) >= need;
    if (ok) { __builtin_amdgcn_fence(__ATOMIC_ACQUIRE, "agent"); asm volatile("s_waitcnt vmcnt(0)" ::: "memory"); }
    return ok;
}
__device__ __forceinline__ void stream_poll_block(unsigned* dep, unsigned need, unsigned* tmo) {
    unsigned spins = 0;
    while ((unsigned)__builtin_amdgcn_readfirstlane(__hip_atomic_load(dep, __ATOMIC_RELAXED, __HIP_MEMORY_SCOPE_AGENT)) < need) {
        __builtin_amdgcn_s_sleep(2);
        if ((++spins & 1023u) == 0u) { if (__hip_atomic_load(tmo, __ATOMIC_RELAXED, __HIP_MEMORY_SCOPE_AGENT) != 0u) break; if (spins > (1u << 21)) { __hip_atomic_store(tmo, 1u, __ATOMIC_RELAXED, __HIP_MEMORY_SCOPE_AGENT); break; } }
    }
    __builtin_amdgcn_fence(__ATOMIC_ACQUIRE, "agent"); asm volatile("s_waitcnt vmcnt(0)" ::: "memory");
}
__device__ __forceinline__ __amdgpu_buffer_rsrc_t mk_rsrc(const void* p) { return __builtin_amdgcn_make_buffer_rsrc(const_cast<void*>(p), 0, 0x7fffffff, 0x00020000); }
__device__ __forceinline__ void st16_wt(__amdgpu_buffer_rsrc_t rs, unsigned off, u32x4 v) { __builtin_amdgcn_raw_buffer_store_b128(v, rs, off, 0, 16); }

struct EpiStream {
    bf16_t *SG1, *SG2;
    const float *xp, *xs; float* H; float* rowss; bf16_t *ACT1, *ACT2;
    __device__ __forceinline__ bool keep(const SU& u) const { return u.kind == K_MIX0; }
    __device__ __forceinline__ void operator()(f32x4 (&acc)[2][2][4][2], const SU& u, int wr, int wc, int fr, int fq) const {
        const int row0 = u.pm * BM + wr * 64 + fr, cl = wc * 32 + 8 * fq;
        if (u.kind == K_MIX0) {
            const size_t o0 = (size_t)row0 * D + u.pn * BM + cl; const bf16_t* g2 = SG2 + o0; const bf16_t* g1 = SG1 + o0;
#pragma unroll
            for (int s = 0; s < 8; ++s) { const int ai = s >> 2, m = s & 3; const size_t off = (size_t)(ai * HALF + m * 16) * D;
#pragma unroll
                for (int bj = 0; bj < 2; ++bj) {
                    f32x4 a0, a1, c0, c1; unpack8(*(const u32x4*)(g2 + off + bj * HALF), a0, a1); unpack8(*(const u32x4*)(g1 + off + bj * HALF), c0, c1);
#pragma unroll
                    for (int j = 0; j < 4; ++j) { acc[ai][bj][m][0][j] *= c0[j] * __builtin_amdgcn_rcpf(fmaxf(a0[j], 1e-30f)); acc[ai][bj][m][1][j] *= c1[j] * __builtin_amdgcn_rcpf(fmaxf(a1[j], 1e-30f)); }
                } }
        } else if (u.kind == K_MIX1) {
            const size_t o0 = (size_t)row0 * D + u.pn * BM + cl; const bf16_t* g2 = SG2 + o0;
            const __amdgpu_buffer_rsrc_t rs = mk_rsrc(SG1); const unsigned ob = (unsigned)o0 * 2u;
            u32x4 gv[2][2];
            gv[0][0] = *(const u32x4*)(g2); gv[0][1] = *(const u32x4*)(g2 + HALF);
#pragma unroll
            for (int s = 0; s < 8; ++s) { const int ai = s >> 2, m = s & 3; const unsigned off = (unsigned)(ai * HALF + m * 16) * D;
                if (s + 1 < 8) { const size_t off2 = (size_t)(((s + 1) >> 2) * HALF + ((s + 1) & 3) * 16) * D;
                    gv[(s + 1) & 1][0] = *(const u32x4*)(g2 + off2); gv[(s + 1) & 1][1] = *(const u32x4*)(g2 + off2 + HALF); }
#pragma unroll
                for (int bj = 0; bj < 2; ++bj) { f32x4 a0, a1; unpack8(gv[s & 1][bj], a0, a1);
                    st16_wt(rs, ob + (off + bj * HALF) * 2u, pack8(acc[ai][bj][m][0] * a0, acc[ai][bj][m][1] * a1)); }
            }
        } else if (u.kind == K_WO) {
            const size_t o0 = (size_t)row0 * D + u.pn * BM + cl;
            const float* xb = ((u.pm < MP / BM) ? xp : xs - (size_t)MP * D) + o0;
            const __amdgpu_buffer_rsrc_t rh = mk_rsrc(H), rb = mk_rsrc(SG2); const unsigned oh = (unsigned)o0 * 4u, obf = (unsigned)o0 * 2u;
            float* rsum = rowss + row0;
            f32x4 xv[2][4];
#define WO_LD(s_, buf_) do { const size_t o_ = (size_t)(((s_) >> 2) * HALF + ((s_) & 3) * 16) * D; \
            xv[buf_][0] = *(const f32x4*)(xb + o_); xv[buf_][1] = *(const f32x4*)(xb + o_ + 4); xv[buf_][2] = *(const f32x4*)(xb + o_ + HALF); xv[buf_][3] = *(const f32x4*)(xb + o_ + HALF + 4); } while (0)
            WO_LD(0, 0);
#pragma unroll
            for (int s = 0; s < 8; ++s) { const int ai = s >> 2, m = s & 3; const unsigned off = (unsigned)(ai * HALF + m * 16) * D;
                if (s + 1 < 8) WO_LD(s + 1, (s + 1) & 1);
                const f32x4 h00 = xv[s & 1][0] + acc[ai][0][m][0], h01 = xv[s & 1][1] + acc[ai][0][m][1], h10 = xv[s & 1][2] + acc[ai][1][m][0], h11 = xv[s & 1][3] + acc[ai][1][m][1];
                st16_wt(rh, oh + off * 4u, __builtin_bit_cast(u32x4, h00)); st16_wt(rh, oh + off * 4u + 16u, __builtin_bit_cast(u32x4, h01));
                st16_wt(rh, oh + (off + HALF) * 4u, __builtin_bit_cast(u32x4, h10)); st16_wt(rh, oh + (off + HALF) * 4u + 16u, __builtin_bit_cast(u32x4, h11));
                st16_wt(rb, obf + off * 2u, pack8(h00, h01)); st16_wt(rb, obf + (off + HALF) * 2u, pack8(h10, h11));
                float ss = (h00[0] * h00[0] + h00[1] * h00[1]) + (h00[2] * h00[2] + h00[3] * h00[3]) + (h01[0] * h01[0] + h01[1] * h01[1]) + (h01[2] * h01[2] + h01[3] * h01[3])
                         + (h10[0] * h10[0] + h10[1] * h10[1]) + (h10[2] * h10[2] + h10[3] * h10[3]) + (h11[0] * h11[0] + h11[1] * h11[1]) + (h11[2] * h11[2] + h11[3] * h11[3]);
                ss += __shfl_xor(ss, 16); ss += __shfl_xor(ss, 32);
                if (fq == 0) __hip_atomic_fetch_add(rsum + ai * HALF + m * 16, ss, __ATOMIC_RELAXED, __HIP_MEMORY_SCOPE_AGENT);
            }
#undef WO_LD
        } else if (u.kind == K_GU) {
            const int ch = 128 * u.pn + cl;
            float rstd[8];
#pragma unroll
            for (int s = 0; s < 8; ++s) rstd[s] = __hip_atomic_load(rowss + row0 + (s >> 2) * HALF + (s & 3) * 16, __ATOMIC_RELAXED, __HIP_MEMORY_SCOPE_AGENT);
#pragma unroll
            for (int s = 0; s < 8; ++s) rstd[s] = __builtin_amdgcn_rsqf(rstd[s] * (1.0f / D) + EPS);
            const bool lo = u.pm < ACT_SPLIT_PM;
            const __amdgpu_buffer_rsrc_t ra = mk_rsrc(lo ? ACT1 : ACT2);
            const unsigned oa = (unsigned)(((size_t)(row0 - (lo ? 0 : ACT_SPLIT_PM * BM)) * FF + ch) * 2);
#pragma unroll
            for (int s = 0; s < 8; ++s) { const int ai = s >> 2, m = s & 3; const float rr = rstd[s];
                f32x4 o[2];
#pragma unroll
                for (int n = 0; n < 2; ++n)
#pragma unroll
                    for (int j = 0; j < 4; ++j) { const float g = acc[ai][0][m][n][j] * rr, up = acc[ai][1][m][n][j] * rr; o[n][j] = g * fsigmoid(g) * up; }
                st16_wt(ra, oa + (unsigned)(ai * HALF + m * 16) * (FF * 2), pack8(o[0], o[1]));
            }
        } else if (u.kind == K_DN0) {
            float* hp = H + (size_t)row0 * D + u.pn * BM + cl;
            f32x4 xv[2][4];
#define DN_LD(s_, buf_) do { const size_t o_ = (size_t)(((s_) >> 2) * HALF + ((s_) & 3) * 16) * D; \
            xv[buf_][0] = *(const f32x4*)(hp + o_); xv[buf_][1] = *(const f32x4*)(hp + o_ + 4); xv[buf_][2] = *(const f32x4*)(hp + o_ + HALF); xv[buf_][3] = *(const f32x4*)(hp + o_ + HALF + 4); } while (0)
            DN_LD(0, 0);
#pragma unroll
            for (int s = 0; s < 8; ++s) { const int ai = s >> 2, m = s & 3; const size_t off = (size_t)(ai * HALF + m * 16) * D;
                if (s + 1 < 8) DN_LD(s + 1, (s + 1) & 1);
                *(f32x4*)(hp + off) = xv[s & 1][0] + acc[ai][0][m][0]; *(f32x4*)(hp + off + 4) = xv[s & 1][1] + acc[ai][0][m][1];
                *(f32x4*)(hp + off + HALF) = xv[s & 1][2] + acc[ai][1][m][0]; *(f32x4*)(hp + off + HALF + 4) = xv[s & 1][3] + acc[ai][1][m][1];
            }
#undef DN_LD
        } else {
            bf16_t* pb = SG1 + (size_t)row0 * D + u.pn * BM + cl;
#pragma unroll
            for (int s = 0; s < 8; ++s) { const int ai = s >> 2, m = s & 3; const size_t off = (size_t)(ai * HALF + m * 16) * D;
#pragma unroll
                for (int bj = 0; bj < 2; ++bj) *(u32x4*)(pb + off + bj * HALF) = pack8(acc[ai][bj][m][0], acc[ai][bj][m][1]); }
        }
    }
};

template <class Epi, class Sched>
__device__ __forceinline__ void gemm_stream(LAS unsigned char* lds, volatile LAS unsigned* flagw, const Sched& S, const Epi& E, unsigned* tmo) {
    const int tid = threadIdx.x, wid = __builtin_amdgcn_readfirstlane(tid >> 6), lane = tid & 63, wr = wid >> 2, wc = wid & 3, fr = lane & 15, fq = lane >> 4;
    int R0, C0; stage_rc(tid * 16, R0, C0); const int Rb0 = (R0 & ~31) + perm32(R0 & 31);
    const size_t kstep = (size_t)(BK * 2);
    const unsigned ldsw = (unsigned)wid * 1024u;
    const int aoff = lds_byte(wr * 64 + fr, fq * 8), boff = lds_byte(wc * 32 + fr, fq * 8);
#define PG8_SA(b, h) (((b) * 2 + (h)) * HTB)
#define PG8_SB(b, h) ((4 + (b) * 2 + (h)) * HTB)
#define PG8_STAGE(bufoff, gbase, voff, rstep) do { \
        __builtin_amdgcn_global_load_lds((const unsigned*)((const char*)(gbase) + (voff)), (LAS unsigned*)(lds + (bufoff) + ldsw), 16, 0, 0); \
        __builtin_amdgcn_global_load_lds((const unsigned*)((const char*)(gbase) + (rstep) + (voff)), (LAS unsigned*)(lds + (bufoff) + ldsw + 8192), 16, 0, 0); } while (0)
#define PG8_LDA(dst, b, h) do { _Pragma("unroll") for (int m = 0; m < 4; ++m) _Pragma("unroll") for (int k = 0; k < 2; ++k) dst[m][k] = *(const LAS bf16x8*)(lds + PG8_SA(b, h) + aoff + m * 2048 + k * 1024); } while (0)
#define PG8_LDB(dst, b, h) do { _Pragma("unroll") for (int n = 0; n < 2; ++n) _Pragma("unroll") for (int k = 0; k < 2; ++k) dst[n][k] = *(const LAS bf16x8*)(lds + PG8_SB(b, h) + boff + n * 2048 + k * 1024); } while (0)
#define PG8_MMA(ai, bj, At, Bt) do { __builtin_amdgcn_s_setprio(1); _Pragma("unroll") for (int m = 0; m < 4; ++m) _Pragma("unroll") for (int n = 0; n < 2; ++n) _Pragma("unroll") for (int k = 0; k < 2; ++k) \
        acc[ai][bj][m][n] = __builtin_amdgcn_mfma_f32_16x16x32_bf16(Bt[n][k], At[m][k], acc[ai][bj][m][n], 0, 0, 0); __builtin_amdgcn_s_setprio(0); } while (0)
#define PG8_WAIT_V(n) asm volatile("s_waitcnt vmcnt(" #n ")" ::: "memory")
#define PG8_WAIT_L(n) asm volatile("s_waitcnt lgkmcnt(" #n ")" ::: "memory")
#define PG8_BAR __builtin_amdgcn_s_barrier()
#define PG8_SCHED __builtin_amdgcn_sched_barrier(0)
#define PG8_ZERO_ACC() do { _Pragma("unroll") for (int a = 0; a < 2; ++a) _Pragma("unroll") for (int b = 0; b < 2; ++b) _Pragma("unroll") for (int m = 0; m < 4; ++m) _Pragma("unroll") for (int n = 0; n < 2; ++n) acc[a][b][m][n] = (f32x4){0.f, 0.f, 0.f, 0.f}; } while (0)
    SU cur, nxt; SParams pc, pq; int ui = 0;
    if (!S.next(0, cur)) return;
    S.params(cur, pc);
    f32x4 acc[2][2][4][2];
    PG8_ZERO_ACC();
    bf16x8 At[4][2], B0[2][2], B1[2][2];
    unsigned known0 = 0u, known1 = 0u, known2 = 0u, known3 = 0u;
#define PG8_KNOWN(idx) ((((idx) < 32 ? known0 : (idx) < 64 ? known1 : (idx) < 96 ? known2 : known3) >> ((idx) & 31)) & 1u)
#define PG8_SETKNOWN(idx) do { const unsigned b_ = 1u << ((idx) & 31); if ((idx) < 32) known0 |= b_; else if ((idx) < 64) known1 |= b_; else if ((idx) < 96) known2 |= b_; else known3 |= b_; } while (0)
    for (;;) {
        if (pc.dep) {
            const int didx = (int)(pc.dep - S.c.cnt) >> 6;
            if (!PG8_KNOWN(didx)) {
                if (wid == 0) stream_poll_block(pc.dep, pc.need, tmo);
                PG8_BAR;
                PG8_SETKNOWN(didx);
            }
        }
        const char* cA = pc.a; const char* cB = pc.b; int nt = pc.nt;
        unsigned vAc = (unsigned)R0 * pc.pitch2 + (unsigned)C0 * 2u, vBc = (unsigned)Rb0 * pc.pitch2 + (unsigned)C0 * 2u;
        size_t rsc = (size_t)64 * pc.pitch2, hsc = (size_t)HALF * pc.pitch2;
        unsigned* pend = nullptr;
        PG8_STAGE(PG8_SB(0, 0), cB, vBc, rsc); PG8_STAGE(PG8_SB(0, 1), cB + hsc, vBc, rsc); PG8_STAGE(PG8_SA(0, 0), cA, vAc, rsc); PG8_STAGE(PG8_SA(0, 1), cA + hsc, vAc, rsc);
        if (wr == 1) PG8_BAR;
        PG8_WAIT_V(2); PG8_BAR;
        PG8_STAGE(PG8_SB(1, 0), cB + kstep, vBc, rsc); PG8_STAGE(PG8_SA(1, 0), cA + kstep, vAc, rsc); PG8_STAGE(PG8_SB(1, 1), cB + hsc + kstep, vBc, rsc);
        PG8_WAIT_V(6); PG8_BAR;
        bool has_next, chain;
        for (;;) {
            has_next = S.next(ui + 1, nxt);
            if (has_next) S.params(nxt, pq); else pq = pc;
            chain = has_next;
            const char* nA = cA; const char* nB = cB; unsigned vAn = vAc, vBn = vBc; size_t rsn = rsc, hsn = hsc;
            for (int t = 0; t < nt; t += 2) {
                const bool last = (t == nt - 2);
                if (last && has_next) {
                    if (pq.dep) {
                        const int didx = (int)(pq.dep - S.c.cnt) >> 6;
                        if (!PG8_KNOWN(didx)) {
                            if (wid == 0) { const bool ok = stream_poll_once(pq.dep, pq.need); if (lane == 0) *flagw = ok ? 1u : 0u; asm volatile("s_waitcnt lgkmcnt(0)" ::: "memory"); }
                            PG8_BAR;
                            chain = (*flagw != 0u);
                            if (chain) PG8_SETKNOWN(didx);
                        }
                    }
                    if (chain) { nA = pq.a; nB = pq.b; vAn = (unsigned)R0 * pq.pitch2 + (unsigned)C0 * 2u; vBn = (unsigned)Rb0 * pq.pitch2 + (unsigned)C0 * 2u; rsn = (size_t)64 * pq.pitch2; hsn = (size_t)HALF * pq.pitch2; }
                }
                const char* a1 = cA + (size_t)(t + 1) * kstep;
                const char* a2 = last ? nA : cA + (size_t)(t + 2) * kstep; const char* b2 = last ? nB : cB + (size_t)(t + 2) * kstep;
                const char* a3 = a2 + kstep; const char* b3 = b2 + kstep;
                const unsigned vA2 = last ? vAn : vAc, vB2 = last ? vBn : vBc; const size_t rs2 = last ? rsn : rsc, hs2 = last ? hsn : hsc;
                PG8_LDB(B0, 0, 0); PG8_LDB(B1, 0, 1); PG8_SCHED; PG8_LDA(At, 0, 0); PG8_STAGE(PG8_SA(1, 1), a1 + hsc, vAc, rsc);
                PG8_WAIT_V(8); PG8_WAIT_L(0); PG8_BAR; PG8_MMA(0, 0, At, B0); PG8_MMA(0, 1, At, B1); PG8_BAR; PG8_SCHED;
                PG8_LDA(At, 0, 1); PG8_STAGE(PG8_SB(0, 0), b2, vB2, rs2); PG8_STAGE(PG8_SB(0, 1), b2 + hs2, vB2, rs2); PG8_STAGE(PG8_SA(0, 0), a2, vA2, rs2);
                PG8_WAIT_V(8); PG8_WAIT_L(0); PG8_BAR; PG8_MMA(1, 0, At, B0); PG8_MMA(1, 1, At, B1); PG8_BAR; PG8_SCHED;
                PG8_LDB(B0, 1, 0); PG8_LDB(B1, 1, 1); PG8_SCHED; PG8_LDA(At, 1, 0); PG8_STAGE(PG8_SA(0, 1), a2 + hs2, vA2, rs2);
                PG8_WAIT_V(8); PG8_WAIT_L(0); PG8_BAR; PG8_MMA(0, 0, At, B0); PG8_MMA(0, 1, At, B1); PG8_BAR; PG8_SCHED;
                PG8_LDA(At, 1, 1); PG8_STAGE(PG8_SB(1, 0), b3, vB2, rs2); PG8_STAGE(PG8_SB(1, 1), b3 + hs2, vB2, rs2); PG8_STAGE(PG8_SA(1, 0), a3, vA2, rs2);
                PG8_WAIT_V(8); PG8_WAIT_L(0); PG8_BAR; PG8_MMA(1, 0, At, B0); PG8_MMA(1, 1, At, B1); PG8_BAR; PG8_SCHED;
                if (t == 0 && pend) { if (lane == 0) __hip_atomic_fetch_add(pend, 1u, __ATOMIC_RELAXED, __HIP_MEMORY_SCOPE_AGENT); pend = nullptr; }
            }
            if (wr == 0) PG8_BAR;
            E(acc, cur, wr, wc, fr, fq);
            pend = pc.pub;
            if (!chain) break;
            if (!E.keep(cur)) PG8_ZERO_ACC();
            cur = nxt; pc = pq; cA = nA; cB = nB; nt = pc.nt; vAc = vAn; vBc = vBn; rsc = rsn; hsc = hsn; ++ui;
            if (wr == 1) PG8_BAR;
        }
        PG8_WAIT_V(0);
        if (pend && lane == 0) __hip_atomic_fetch_add(pend, 1u, __ATOMIC_RELAXED, __HIP_MEMORY_SCOPE_AGENT);
        PG8_BAR;
        if (!has_next) break;
        PG8_ZERO_ACC();
        cur = nxt; pc = pq; ++ui;
    }
#undef PG8_SA
#undef PG8_SB
#undef PG8_STAGE
#undef PG8_LDA
#undef PG8_LDB
#undef PG8_MMA
#undef PG8_WAIT_V
#undef PG8_WAIT_L
#undef PG8_BAR
#undef PG8_SCHED
#undef PG8_ZERO_ACC
#undef PG8_KNOWN
#undef PG8_SETKNOWN
}
}

#define XB_TMO      128
#define XB_XCNT(j)  (256  + 64 * (j))
#define XB_XSUB(j)  (1280 + 64 * (j))
#define XB_XGEN(j)  (2304 + 64 * (j))
#define XB_TOP      3328
#define XB_TOPGEN   3392
#define XCD_BAR_WORDS 3456
#define XB_SPIN_CAP (1u << 18)
__device__ __forceinline__ unsigned xb_ld(unsigned* p)              { return __hip_atomic_load(p, __ATOMIC_RELAXED, __HIP_MEMORY_SCOPE_AGENT); }
__device__ __forceinline__ unsigned xb_add(unsigned* p, unsigned v) { return __hip_atomic_fetch_add(p, v, __ATOMIC_RELAXED, __HIP_MEMORY_SCOPE_AGENT); }
__device__ __forceinline__ unsigned xb_xcc_id() { return (unsigned)__builtin_amdgcn_s_getreg((3 << 11) | 20) & 0xFu; }
#define XB_SPIN(cond, bar) do { unsigned _sp = 0; while (cond) { __builtin_amdgcn_s_sleep(1); \
    if ((++_sp & 255u) == 0u) { if (xb_ld(&(bar)[XB_TMO])) break; if (_sp > XB_SPIN_CAP) { atomicAdd(&(bar)[XB_TMO], 1u); break; } } } } while (0)
struct XcdBarrier { unsigned* bar; unsigned x; volatile LAS unsigned* st; };
__device__ __forceinline__ XcdBarrier xcd_barrier_post(unsigned* bar, volatile LAS unsigned* st) {
    XcdBarrier b; b.bar = bar; b.x = xb_xcc_id(); b.st = st;
    if (threadIdx.x == 0) (void)xb_add(&bar[XB_XCNT(b.x)], 1u);
    return b;
}
__device__ __forceinline__ void xcd_barrier_complete(unsigned* bar, unsigned x, unsigned& nloc, unsigned& nx) {
    const unsigned G = gridDim.x * gridDim.y * gridDim.z;
    unsigned sum, cnt, mine, sp = 0u;
    for (;;) {
        sum = 0u; cnt = 0u; mine = 0u;
#pragma unroll
        for (unsigned j = 0; j < 16; ++j) { const unsigned c = xb_ld(&bar[XB_XCNT(j)]); sum += c; cnt += (c > 0u) ? 1u : 0u; mine = (j == x) ? c : mine; }
        if (sum == G) break;
        __builtin_amdgcn_s_sleep(1);
        if ((++sp & 255u) == 0u) { if (xb_ld(&bar[XB_TMO])) break; if (sp > XB_SPIN_CAP) { atomicAdd(&bar[XB_TMO], 1u); break; } }
    }
    nloc = mine > 0u ? mine : 1u; nx = cnt > 0u ? cnt : 1u;
}
__device__ __forceinline__ void xcd_barrier(const XcdBarrier& b) {
    asm volatile("s_waitcnt vmcnt(0)" ::: "memory");
    __syncthreads();
    if (threadIdx.x == 0) {
        unsigned* bar = b.bar;
        __builtin_amdgcn_s_waitcnt(0);
        unsigned nloc = b.st[0], nx = b.st[1];
        if (nloc == 0u) { xcd_barrier_complete(bar, b.x, nloc, nx); b.st[0] = nloc; b.st[1] = nx; }
        const unsigned old = xb_add(&bar[XB_XSUB(b.x)], 1u);
        const unsigned gen = old / nloc;
        if (old + 1u == (gen + 1u) * nloc) {
            __builtin_amdgcn_fence(__ATOMIC_RELEASE, "agent");
            asm volatile("s_waitcnt vmcnt(0)" ::: "memory");
            const unsigned og = xb_add(&bar[XB_TOP], 1u);
            const unsigned tg = og / nx;
            if (og + 1u == (tg + 1u) * nx) xb_add(&bar[XB_TOPGEN], 1u);
            else XB_SPIN(xb_ld(&bar[XB_TOPGEN]) == tg, bar);
            __builtin_amdgcn_fence(__ATOMIC_ACQUIRE, "agent");
            xb_add(&bar[XB_XGEN(b.x)], 1u);
            asm volatile("s_waitcnt vmcnt(0)" ::: "memory");
        } else {
            XB_SPIN(xb_ld(&bar[XB_XGEN(b.x)]) == gen, bar);
            __builtin_amdgcn_fence(__ATOMIC_ACQUIRE, "agent");
            asm volatile("s_waitcnt vmcnt(0)" ::: "memory");
        }
    }
    __syncthreads();
}

struct Args {
    const float *x_prompt, *x_sample, *cache_k, *cache_v, *state_conv, *rel_bias, *w_in, *w_conv, *w_conv_out, *sinks, *w_attn_out, *w_o, *g_mix, *g_ffn, *w_gate, *w_up, *w_down, *g_final;
    float* out; unsigned char* ws; int ph_lo, ph_hi;
};
struct Frame { LAS unsigned char* lds; int tid, lane, wave, vcu, G; };

static __device__ const unsigned char T5_BUCKET[128] = {
    0, 1, 2, 3, 4, 5, 6, 7, 8, 9, 10, 11, 12, 13, 14, 15, 16, 16, 16, 17, 17, 18, 18, 18, 19, 19, 19, 20, 20, 20, 20, 21, 21, 21, 21, 22, 22, 22, 22, 22, 23, 23, 23, 23, 23, 23,
    24, 24, 24, 24, 24, 24, 25, 25, 25, 25, 25, 25, 25, 26, 26, 26, 26, 26, 26, 26, 26, 27, 27, 27, 27, 27, 27, 27, 27, 27, 27, 28, 28, 28, 28, 28, 28, 28, 28, 28, 28,
    29, 29, 29, 29, 29, 29, 29, 29, 29, 29, 29, 29, 30, 30, 30, 30, 30, 30, 30, 30, 30, 30, 30, 30, 30, 30, 31, 31, 31, 31, 31, 31, 31, 31, 31, 31, 31, 31, 31, 31, 31};

constexpr int P0_PITCH = 520;
struct P0Item { const float* W; bf16_t* WT; const float* gk; int K, N, k0, n0, dr; };
__device__ __forceinline__ bool p0_decode(const Args& a, unsigned char* ws, int it, P0Item& q) {
    constexpr int T_IN = (D / 128) * (NIN / 128), T_C = (DC / 128) * (D / 128), T_A = T_C, T_O = (D / 128) * (D / 128), T_G = (D / 128) * (FF / 128), T_U = T_G, T_D = (FF / 128) * (D / 128);
    int r = it; q.gk = nullptr;
    if (r < T_IN) { const int nb = NIN / 128; q.W = a.w_in; q.WT = (bf16_t*)(ws + WS_WIN); q.K = D; q.N = NIN; q.k0 = 128 * (r / nb); q.n0 = 128 * (r % nb);
        const int n0 = q.n0; q.dr = n0 < 1024 ? n0 : n0 < 2048 ? 1024 + 2 * (n0 - 1024) : n0 < 3072 ? 1024 + 2 * (n0 - 2048) + 128 : n0; return true; } r -= T_IN;
    if (r < T_C) { const int nb = D / 128; q.W = a.w_conv_out; q.WT = (bf16_t*)(ws + WS_WC); q.K = DC; q.N = D; q.k0 = 128 * (r / nb); q.n0 = 128 * (r % nb); q.dr = q.n0; return true; } r -= T_C;
    if (r < T_A) { const int nb = D / 128; q.W = a.w_attn_out; q.WT = (bf16_t*)(ws + WS_WA); q.K = DA; q.N = D; q.k0 = 128 * (r / nb); q.n0 = 128 * (r % nb); q.dr = q.n0; return true; } r -= T_A;
    if (r < T_O) { const int nb = D / 128; q.W = a.w_o; q.WT = (bf16_t*)(ws + WS_WO); q.K = D; q.N = D; q.k0 = 128 * (r / nb); q.n0 = 128 * (r % nb); q.dr = q.n0; return true; } r -= T_O;
    if (r < T_G) { const int nb = FF / 128; q.W = a.w_gate; q.WT = (bf16_t*)(ws + WS_WGU); q.gk = a.g_ffn; q.K = D; q.N = FF; q.k0 = 128 * (r / nb); q.n0 = 128 * (r % nb); q.dr = 2 * q.n0; return true; } r -= T_G;
    if (r < T_U) { const int nb = FF / 128; q.W = a.w_up; q.WT = (bf16_t*)(ws + WS_WGU); q.gk = a.g_ffn; q.K = D; q.N = FF; q.k0 = 128 * (r / nb); q.n0 = 128 * (r % nb); q.dr = 2 * q.n0 + 128; return true; } r -= T_U;
    if (r < T_D) { const int nb = D / 128; q.W = a.w_down; q.WT = (bf16_t*)(ws + WS_WD); q.K = FF; q.N = D; q.k0 = 128 * (r / nb); q.n0 = 128 * (r % nb); q.dr = q.n0; return true; }
    return false;
}
__device__ __forceinline__ void p0_load(const P0Item& q, int tid, f32x4 (&v)[8]) {
    const int c4 = tid & 31, kr = tid >> 5;
#pragma unroll
    for (int i = 0; i < 4; ++i) { const int k = q.k0 + 2 * (kr + 16 * i); const float* p = q.W + (size_t)k * q.N + q.n0 + 4 * c4;
        v[2 * i] = *(const f32x4*)p; v[2 * i + 1] = *(const f32x4*)(p + q.N);
        if (q.gk) { const float g0 = q.gk[k], g1 = q.gk[k + 1]; v[2 * i] = v[2 * i] * g0; v[2 * i + 1] = v[2 * i + 1] * g1; } }
}
__device__ __forceinline__ void p0_prologue(const Frame& F, const Args& a) {
    unsigned char* ws = a.ws;
    LAS unsigned char* T2 = F.lds;
    const int tid = F.tid;
    constexpr int NITEMS = (D / 128) * (NIN / 128) + 2 * (DC / 128) * (D / 128) + (D / 128) * (D / 128) + 2 * (D / 128) * (FF / 128) + (FF / 128) * (D / 128);
    { float* rs = (float*)((unsigned*)(ws + WS_CTL) + CW_ROWSS); for (int i = F.vcu * (NWAVES * 64) + tid; i < M; i += F.G * (NWAVES * 64)) rs[i] = 0.f;
      if (blockIdx.x == 0 && tid < 3 * 36) ((unsigned*)(ws + WS_CTL))[CW_CNT + tid * 64] = 0u; }
    P0Item q, qn; f32x4 v[8];
    int it = F.vcu; bool have = p0_decode(a, ws, it, q);
    if (have) p0_load(q, tid, v);
    while (have) {
        { const int c4 = tid & 31, kr = tid >> 5;
#pragma unroll
          for (int i = 0; i < 4; ++i) { u32x4 w; w.x = cvt_pk_bf16(v[2 * i][0], v[2 * i + 1][0]); w.y = cvt_pk_bf16(v[2 * i][1], v[2 * i + 1][1]); w.z = cvt_pk_bf16(v[2 * i][2], v[2 * i + 1][2]); w.w = cvt_pk_bf16(v[2 * i][3], v[2 * i + 1][3]);
              LAS unsigned char* tp = T2 + (kr + 16 * i) * P0_PITCH + c4 * 16; *(LAS u32x2*)tp = (u32x2){w.x, w.y}; *(LAS u32x2*)(tp + 8) = (u32x2){w.z, w.w}; } }
        __syncthreads();
        it += F.G; const bool hn = p0_decode(a, ws, it, qn);
        if (hn) p0_load(qn, tid, v);
        { const int k8 = tid & 15, nr = tid >> 4;
#pragma unroll
          for (int i = 0; i < 4; ++i) { const int n = nr + 32 * i; LAS const unsigned char* p = T2 + (4 * k8) * P0_PITCH + n * 4;
              u32x4 o; o.x = *(LAS const unsigned*)(p); o.y = *(LAS const unsigned*)(p + P0_PITCH); o.z = *(LAS const unsigned*)(p + 2 * P0_PITCH); o.w = *(LAS const unsigned*)(p + 3 * P0_PITCH);
              *(u32x4*)(q.WT + (size_t)(q.dr + n) * q.K + q.k0 + 8 * k8) = o; } }
        __syncthreads();
        q = qn; have = hn;
    }
    const int gw = F.vcu * NWAVES + F.wave, NGW = F.G * NWAVES;
    bf16_t* XN = (bf16_t*)(ws + WS_XN);
    for (int m = gw; m < M; m += NGW) {
        const float* xrow = (m < MP) ? a.x_prompt + (size_t)m * D : a.x_sample + (size_t)(m - MP) * D;
        const f32x4* xr = (const f32x4*)xrow + F.lane; const f32x4* gr = (const f32x4*)a.g_mix + F.lane;
        f32x4 xv[8]; float s = 0.f;
#pragma unroll
        for (int j = 0; j < 8; ++j) { xv[j] = xr[64 * j]; s += (xv[j][0] * xv[j][0] + xv[j][1] * xv[j][1]) + (xv[j][2] * xv[j][2] + xv[j][3] * xv[j][3]); }
        const float rstd = __builtin_amdgcn_rsqf(wave_sum(s) * (1.0f / D) + EPS);
        u32x2* o8 = (u32x2*)(XN + (size_t)m * D) + F.lane;
#pragma unroll
        for (int j = 0; j < 8; ++j) { const f32x4 g = gr[64 * j]; u32x2 w; w.x = cvt_pk_bf16(xv[j][0] * rstd * g[0], xv[j][1] * rstd * g[1]); w.y = cvt_pk_bf16(xv[j][2] * rstd * g[2], xv[j][3] * rstd * g[3]); o8[64 * j] = w; }
    }
}

constexpr int KIMG_STRIDE = 144, VT_STRIDE = 528;
constexpr int LDS_KIMG = 0, LDS_VT = 256 * KIMG_STRIDE, LDS_LUT = LDS_VT + 64 * VT_STRIDE, LDS_SINK = LDS_LUT + 4 * 128 * 4;
static_assert(LDS_SINK + 16 <= RING_BYTES, "attention LDS");

__device__ __forceinline__ void attn_group(LAS const unsigned char* lds, const int key0, const bf16x8 q0, const bf16x8 q1, const int dist0, const int min_krow, const int hl, bf16_t* outp, const int lane) {
    const int l15 = lane & 15, g = lane >> 4;
    f32x4 s[10];
    LAS const unsigned char* kp = lds + LDS_KIMG + (key0 + l15) * KIMG_STRIDE + g * 16;
#pragma unroll
    for (int T = 0; T < 10; ++T) {
        const bf16x8 k0f = *(LAS const bf16x8*)(kp + T * 16 * KIMG_STRIDE), k1f = *(LAS const bf16x8*)(kp + T * 16 * KIMG_STRIDE + 64);
        f32x4 a = (f32x4){0.f, 0.f, 0.f, 0.f};
        a = __builtin_amdgcn_mfma_f32_16x16x32_bf16(k0f, q0, a, 0, 0, 0);
        a = __builtin_amdgcn_mfma_f32_16x16x32_bf16(k1f, q1, a, 0, 0, 0);
        s[T] = a;
    }
    LAS const float* lut = (LAS const float*)(lds + LDS_LUT) + hl * 128;
    float mx = -INFINITY;
#pragma unroll
    for (int T = 0; T < 10; ++T)
#pragma unroll
        for (int r = 0; r < 4; ++r) {
            const int kk = 16 * T + 4 * g + r, dist = dist0 - kk;
            const bool valid = ((unsigned)dist < 128u) && (key0 + kk >= min_krow);
            const float v = valid ? s[T][r] + lut[dist & 127] : -INFINITY;
            s[T][r] = v; mx = fmaxf(mx, v);
        }
    mx = fmaxf(mx, __shfl_xor(mx, 16)); mx = fmaxf(mx, __shfl_xor(mx, 32));
    const float sink = ((LAS const float*)(lds + LDS_SINK))[hl];
    mx = fmaxf(mx, sink);
    float sum = 0.f;
#pragma unroll
    for (int T = 0; T < 10; ++T)
#pragma unroll
        for (int r = 0; r < 4; ++r) { const float p = __expf(s[T][r] - mx); s[T][r] = p; sum += p; }
    sum += __shfl_xor(sum, 16); sum += __shfl_xor(sum, 32);
    sum += __expf(sink - mx);
    const float inv = 1.0f / sum;
    bf16x8 pf[5];
#pragma unroll
    for (int P = 0; P < 5; ++P) pf[P] = __builtin_bit_cast(bf16x8, pg8::pack8(s[2 * P] * inv, s[2 * P + 1] * inv));
#pragma unroll
    for (int dt = 0; dt < 4; ++dt) {
        f32x4 o = (f32x4){0.f, 0.f, 0.f, 0.f};
        LAS const unsigned char* vp = lds + LDS_VT + (16 * dt + l15) * VT_STRIDE + (key0 + 4 * g) * 2;
#pragma unroll
        for (int P = 0; P < 5; ++P) {
            const u32x2 lo = *(LAS const u32x2*)(vp + 64 * P), hi = *(LAS const u32x2*)(vp + 64 * P + 32);
            const bf16x8 vf = __builtin_bit_cast(bf16x8, (u32x4){lo.x, lo.y, hi.x, hi.y});
            o = __builtin_amdgcn_mfma_f32_16x16x32_bf16(vf, pf[P], o, 0, 0, 0);
        }
        u32x2 w; w.x = cvt_pk_bf16(o[0], o[1]); w.y = cvt_pk_bf16(o[2], o[3]);
        *(u32x2*)(outp + 16 * dt + 4 * g) = w;
    }
}

__device__ __forceinline__ void p2_attention_conv(const Frame& F, const Args& a) {
    unsigned char* ws = a.ws;
    const bf16_t* Qb = (const bf16_t*)(ws + WS_Q); const bf16_t* Kb = (const bf16_t*)(ws + WS_K); const bf16_t* Vb = (const bf16_t*)(ws + WS_V);
    bf16_t* ATT = (bf16_t*)(ws + WS_ATT);
    LAS unsigned char* lds = F.lds;
    const int tid = F.tid, lane = F.lane, wave = F.wave, l15 = lane & 15, g = lane >> 4;
    for (int u = blockIdx.x; u < NBATCH * 16 * 4; u += F.G) {
        const int b = u >> 6, nb = (u >> 2) & 15, kvh = u & 3;
        __syncthreads();
        {
            const int hl = tid >> 7, dist = tid & 127;
            ((LAS float*)(lds + LDS_LUT))[tid] = a.rel_bias[T5_BUCKET[dist] * 16 + kvh * 4 + hl];
            if (tid < 4) ((LAS float*)(lds + LDS_SINK))[tid] = a.sinks[kvh * 4 + tid];
        }
#pragma unroll
        for (int i = 0; i < 4; ++i) {
            const int id = tid + 512 * i, r = id >> 3, c8 = id & 7, t = nb * WIN - WIN + r;
            u32x4 kv = (u32x4){0u, 0u, 0u, 0u}, vv = (u32x4){0u, 0u, 0u, 0u};
            if (t >= 0) { const size_t off = (size_t)(b * SEQ + t) * DKV + kvh * 64 + c8 * 8; kv = *(const u32x4*)(Kb + off); vv = *(const u32x4*)(Vb + off); }
            *(LAS u32x4*)(lds + LDS_KIMG + r * KIMG_STRIDE + c8 * 16) = kv;
            LAS unsigned char* vt = lds + LDS_VT + (c8 * 8) * VT_STRIDE + r * 2;
            *(LAS bf16_t*)(vt + 0 * VT_STRIDE) = (bf16_t)(vv.x & 0xffffu); *(LAS bf16_t*)(vt + 1 * VT_STRIDE) = (bf16_t)(vv.x >> 16);
            *(LAS bf16_t*)(vt + 2 * VT_STRIDE) = (bf16_t)(vv.y & 0xffffu); *(LAS bf16_t*)(vt + 3 * VT_STRIDE) = (bf16_t)(vv.y >> 16);
            *(LAS bf16_t*)(vt + 4 * VT_STRIDE) = (bf16_t)(vv.z & 0xffffu); *(LAS bf16_t*)(vt + 5 * VT_STRIDE) = (bf16_t)(vv.z >> 16);
            *(LAS bf16_t*)(vt + 6 * VT_STRIDE) = (bf16_t)(vv.w & 0xffffu); *(LAS bf16_t*)(vt + 7 * VT_STRIDE) = (bf16_t)(vv.w >> 16);
        }
        __syncthreads();
        const int hl = wave >> 1, head = kvh * 4 + hl;
#pragma unroll 1
        for (int i = 0; i < 4; ++i) {
            const int qg = (wave & 1) * 4 + i, qi0 = 16 * qg, key0 = 16 * (qg & ~1);
            const size_t row = (size_t)b * SEQ + nb * WIN + qi0 + l15;
            const bf16_t* qp = Qb + row * DA + head * 64 + 8 * g;
            const bf16x8 q0 = *(const bf16x8*)qp, q1 = *(const bf16x8*)(qp + 32);
            attn_group(lds, key0, q0, q1, qi0 + l15 + WIN - key0, nb == 0 ? WIN : 0, hl, ATT + row * DA + head * 64, lane);
        }
    }
    for (int u = blockIdx.x; u < DBATCH * 4; u += F.G) {
        const int b = u >> 2, kvh = u & 3;
        __syncthreads();
        {
            const int hl = tid >> 7, dist = tid & 127;
            ((LAS float*)(lds + LDS_LUT))[tid] = a.rel_bias[T5_BUCKET[dist] * 16 + kvh * 4 + hl];
            if (tid < 4) ((LAS float*)(lds + LDS_SINK))[tid] = a.sinks[kvh * 4 + tid];
        }
#pragma unroll
        for (int i = 0; i < 4; ++i) {
            const int id = tid + 512 * i, j = id >> 4, c4 = id & 15;
            const size_t off = ((size_t)(b * WIN + j) * 4 + kvh) * 64 + c4 * 4;
            const f32x4 kf = *(const f32x4*)(a.cache_k + off), vf = *(const f32x4*)(a.cache_v + off);
            if (j >= DSEQ) { const size_t oo = ((size_t)(b * WIN + j - DSEQ) * 4 + kvh) * 64 + c4 * 4; *(f32x4*)(a.out + OUT_KS + oo) = kf; *(f32x4*)(a.out + OUT_VS + oo) = vf; }
            u32x2 kw; kw.x = cvt_pk_bf16(kf[0], kf[1]); kw.y = cvt_pk_bf16(kf[2], kf[3]);
            *(LAS u32x2*)(lds + LDS_KIMG + j * KIMG_STRIDE + c4 * 8) = kw;
            const unsigned v01 = cvt_pk_bf16(vf[0], vf[1]), v23 = cvt_pk_bf16(vf[2], vf[3]);
            LAS unsigned char* vt = lds + LDS_VT + (c4 * 4) * VT_STRIDE + j * 2;
            *(LAS bf16_t*)(vt + 0 * VT_STRIDE) = (bf16_t)(v01 & 0xffffu); *(LAS bf16_t*)(vt + 1 * VT_STRIDE) = (bf16_t)(v01 >> 16);
            *(LAS bf16_t*)(vt + 2 * VT_STRIDE) = (bf16_t)(v23 & 0xffffu); *(LAS bf16_t*)(vt + 3 * VT_STRIDE) = (bf16_t)(v23 >> 16);
        }
        if (tid < 256) {
            const int r = WIN + (tid >> 3), c8 = tid & 7;
            u32x4 kv = (u32x4){0u, 0u, 0u, 0u}, vv = (u32x4){0u, 0u, 0u, 0u};
            if (r < WIN + DSEQ) { const size_t off = (size_t)(MP + b * DSEQ + (r - WIN)) * DKV + kvh * 64 + c8 * 8; kv = *(const u32x4*)(Kb + off); vv = *(const u32x4*)(Vb + off); }
            *(LAS u32x4*)(lds + LDS_KIMG + r * KIMG_STRIDE + c8 * 16) = kv;
            LAS unsigned char* vt = lds + LDS_VT + (c8 * 8) * VT_STRIDE + r * 2;
            *(LAS bf16_t*)(vt + 0 * VT_STRIDE) = (bf16_t)(vv.x & 0xffffu); *(LAS bf16_t*)(vt + 1 * VT_STRIDE) = (bf16_t)(vv.x >> 16);
            *(LAS bf16_t*)(vt + 2 * VT_STRIDE) = (bf16_t)(vv.y & 0xffffu); *(LAS bf16_t*)(vt + 3 * VT_STRIDE) = (bf16_t)(vv.y >> 16);
            *(LAS bf16_t*)(vt + 4 * VT_STRIDE) = (bf16_t)(vv.z & 0xffffu); *(LAS bf16_t*)(vt + 5 * VT_STRIDE) = (bf16_t)(vv.z >> 16);
            *(LAS bf16_t*)(vt + 6 * VT_STRIDE) = (bf16_t)(vv.w & 0xffffu); *(LAS bf16_t*)(vt + 7 * VT_STRIDE) = (bf16_t)(vv.w >> 16);
        }
        __syncthreads();
        if (wave < 2) {
            const int t = l15 & 7, hl = 2 * wave + (l15 >> 3), head = kvh * 4 + hl;
            const size_t row = (size_t)MP + b * DSEQ + t;
            const bf16_t* qp = Qb + row * DA + head * 64 + 8 * g;
            const bf16x8 q0 = *(const bf16x8*)qp, q1 = *(const bf16x8*)(qp + 32);
            attn_group(lds, 0, q0, q1, t + WIN, 0, hl, ATT + row * DA + head * 64, lane);
        }
    }
    __syncthreads();
    {
        const bf16_t* U = (const bf16_t*)(ws + WS_U); const bf16_t* Bg = (const bf16_t*)(ws + WS_BG); bf16_t* AC = (bf16_t*)(ws + WS_ACONV);
        for (int id = blockIdx.x * (NWAVES * 64) + tid; id < M * (DC / 8); id += F.G * (NWAVES * 64)) {
            const int row = id >> 7, c = (id & 127) * 8;
            f32x4 u2a, u2b, u1a, u1b, u0a, u0b, ba, bb;
            pg8::unpack8(*(const u32x4*)(U + (size_t)row * DC + c), u0a, u0b);
            pg8::unpack8(*(const u32x4*)(Bg + (size_t)row * DC + c), ba, bb);
            int t; const float* st = nullptr;
            if (row < MP) t = row & (SEQ - 1); else { const int s = row - MP; t = s & 7; st = a.state_conv + (size_t)(s >> 3) * 2 * DC + c; }
            if (t >= 1) pg8::unpack8(*(const u32x4*)(U + (size_t)(row - 1) * DC + c), u1a, u1b);
            else if (st) { u1a = *(const f32x4*)(st + DC); u1b = *(const f32x4*)(st + DC + 4); }
            else { u1a = (f32x4){0.f, 0.f, 0.f, 0.f}; u1b = u1a; }
            if (t >= 2) pg8::unpack8(*(const u32x4*)(U + (size_t)(row - 2) * DC + c), u2a, u2b);
            else if (st) { const float* p = st + (t == 1 ? DC : 0); u2a = *(const f32x4*)p; u2b = *(const f32x4*)(p + 4); }
            else { u2a = (f32x4){0.f, 0.f, 0.f, 0.f}; u2b = u2a; }
            const f32x4 w0a = *(const f32x4*)(a.w_conv + c), w0b = *(const f32x4*)(a.w_conv + c + 4), w1a = *(const f32x4*)(a.w_conv + DC + c), w1b = *(const f32x4*)(a.w_conv + DC + c + 4),
                        w2a = *(const f32x4*)(a.w_conv + 2 * DC + c), w2b = *(const f32x4*)(a.w_conv + 2 * DC + c + 4);
            const f32x4 oa = ba * (w0a * u2a + w1a * u1a + w2a * u0a), ob = bb * (w0b * u2b + w1b * u1b + w2b * u0b);
            *(u32x4*)(AC + (size_t)row * DC + c) = pg8::pack8(oa, ob);
        }
    }
}

__device__ __forceinline__ void p7_final_norm(const Frame& F, const Args& a) {
    const int gw = F.vcu * NWAVES + F.wave, NGW = F.G * NWAVES;
    for (int m = gw; m < M; m += NGW) {
        f32x4* xr = (f32x4*)(a.out + OUT_Y + (size_t)m * D) + F.lane; const f32x4* gr = (const f32x4*)a.g_final + F.lane;
        f32x4 v[8]; float s = 0.f;
        const u32x2* pr = (const u32x2*)((const bf16_t*)(a.ws + WS_SG1) + (size_t)m * D) + F.lane;
#pragma unroll
        for (int j = 0; j < 8; ++j) { const u32x2 pw = pr[64 * j]; v[j] = xr[64 * j] + (f32x4){bf_lo(pw.x), bf_hi(pw.x), bf_lo(pw.y), bf_hi(pw.y)}; s += (v[j][0] * v[j][0] + v[j][1] * v[j][1]) + (v[j][2] * v[j][2] + v[j][3] * v[j][3]); }
        const float rstd = __builtin_amdgcn_rsqf(wave_sum(s) * (1.0f / D) + EPS);
#pragma unroll
        for (int j = 0; j < 8; ++j) xr[64 * j] = v[j] * rstd * gr[64 * j];
    }
}

constexpr int N_PHASES = 5;
__global__ void __launch_bounds__(NWAVES * 64, 2) fwd_kernel(Args args) {
    extern __shared__ __attribute__((aligned(16))) unsigned char lds_raw[];
    Frame F;
    F.lds = (LAS unsigned char*)lds_raw;
    F.tid = threadIdx.x; F.lane = F.tid & 63; F.wave = __builtin_amdgcn_readfirstlane(F.tid >> 6);
    F.G = gridDim.x; { const int bx = blockIdx.x; F.vcu = (F.G % 8 == 0) ? (bx % 8) * (F.G / 8) + bx / 8 : bx; }
    unsigned char* ws = args.ws;
    unsigned* ctl = (unsigned*)(ws + WS_CTL);
    volatile LAS unsigned* MISC = (volatile LAS unsigned*)(F.lds + MISC_OFF);
    for (int u = F.tid; u < (LDS_BYTES - LDSCTL_OFF) / 4; u += NWAVES * 64) ((LAS unsigned*)(F.lds + LDSCTL_OFF))[u] = 0u;
    __syncthreads();
    XcdBarrier bar; bar.bar = ctl + CW_BAR; bar.x = 0; bar.st = nullptr;
    if (MK_N_LAUNCHES == 1) bar = xcd_barrier_post(ctl + CW_BAR, MISC + 8);
    const int lo = args.ph_lo, hi = args.ph_hi;
#define IN(k) (lo <= (k) && (k) < hi)
#define SEAM(k) do { if (IN(k) && IN((k) + 1)) xcd_barrier(bar); } while (0)
    float* rowss = (float*)(ctl + CW_ROWSS);

#ifndef REP0
#define REP0 1
#endif
#ifndef REP2
#define REP2 1
#endif
    if (IN(0)) { for (int rep = 0; rep < REP0; ++rep) { p0_prologue(F, args); SEAM(0); } }
    if (IN(1)) {
        pg8::SchedG S; S.o.init(M / 256, NIN / 256, F.G, (int)blockIdx.x); S.A = (const char*)(ws + WS_XN); S.B = (const char*)(ws + WS_WIN); S.tstep = (size_t)256 * D * 2;
        pg8::EpiIn E{(bf16_t*)(ws + WS_BG), (bf16_t*)(ws + WS_U), (bf16_t*)(ws + WS_Q), (bf16_t*)(ws + WS_K), (bf16_t*)(ws + WS_V), (bf16_t*)(ws + WS_SG1), (bf16_t*)(ws + WS_SG2), args.out};
        pg8::gemm_phase(F.lds, D, S, E);
        SEAM(1);
    }
    if (IN(2)) { for (int rep = 0; rep < REP2; ++rep) { p2_attention_conv(F, args); SEAM(2); } }
    if (IN(3)) {
        pg8::StreamSched S; S.x = F.vcu >> 5; S.r = F.vcu & 31;
        S.c.ACONV = (const char*)(ws + WS_ACONV); S.c.ATT = (const char*)(ws + WS_ATT); S.c.WC = (const char*)(ws + WS_WC); S.c.WA = (const char*)(ws + WS_WA);
        S.c.MERGED = (const char*)(ws + WS_SG1); S.c.WO = (const char*)(ws + WS_WO); S.c.HB = (const char*)(ws + WS_SG2); S.c.WGU = (const char*)(ws + WS_WGU);
        S.c.ACT1 = (const char*)(ws + WS_ACT1); S.c.ACT2 = (const char*)(ws + WS_ACT2); S.c.WD = (const char*)(ws + WS_WD); S.c.cnt = ctl + CW_CNT;
        pg8::EpiStream E{(bf16_t*)(ws + WS_SG1), (bf16_t*)(ws + WS_SG2), args.x_prompt, args.x_sample, args.out + OUT_Y, rowss, (bf16_t*)(ws + WS_ACT1), (bf16_t*)(ws + WS_ACT2)};
        pg8::gemm_stream(F.lds, MISC + 16, S, E, ctl + CW_TMO);
        SEAM(3);
    }
    if (IN(4)) { p7_final_norm(F, args); }
#undef IN
#undef SEAM
}

extern "C" void kernel_launch(void* const* d_in, const int* in_sizes, int n_in, void* d_out, int out_size, void* d_ws, size_t ws_size, hipStream_t stream) {
    static int grid = 0;
    if (grid == 0) {
        if (n_in != 18 || (size_t)out_size != OUT_END || ws_size < WS_END) { fprintf(stderr, "kernel_launch: unexpected shapes: n_in %d out %d ws %zu (need %zu)\n", n_in, out_size, ws_size, (size_t)WS_END); grid = -1; return; }
        int dev = 0, cus = 0, per_cu = 0;
        if (hipGetDevice(&dev) != hipSuccess || hipDeviceGetAttribute(&cus, hipDeviceAttributeMultiprocessorCount, dev) != hipSuccess) { grid = -1; return; }
        if (hipFuncSetAttribute((const void*)fwd_kernel, hipFuncAttributeMaxDynamicSharedMemorySize, LDS_BYTES) != hipSuccess) { fprintf(stderr, "kernel_launch: hipFuncSetAttribute failed\n"); grid = -1; return; }
        if (hipOccupancyMaxActiveBlocksPerMultiprocessor(&per_cu, (const void*)fwd_kernel, NWAVES * 64, LDS_BYTES) != hipSuccess || per_cu < 1) { fprintf(stderr, "kernel_launch: occupancy query says %d blocks per CU\n", per_cu); per_cu = 1; }
        (void)hipGetLastError();
        grid = cus;
    }
    if (grid < 0) return;
    (void)hipMemsetAsync((char*)d_ws + WS_CTL, 0, CTL_ZERO_BYTES, stream);
    Args a{};
    a.x_prompt = (const float*)d_in[0]; a.x_sample = (const float*)d_in[1]; a.cache_k = (const float*)d_in[2]; a.cache_v = (const float*)d_in[3]; a.state_conv = (const float*)d_in[4];
    a.rel_bias = (const float*)d_in[5]; a.w_in = (const float*)d_in[6]; a.w_conv = (const float*)d_in[7]; a.w_conv_out = (const float*)d_in[8]; a.sinks = (const float*)d_in[9];
    a.w_attn_out = (const float*)d_in[10]; a.w_o = (const float*)d_in[11]; a.g_mix = (const float*)d_in[12]; a.g_ffn = (const float*)d_in[13]; a.w_gate = (const float*)d_in[14];
    a.w_up = (const float*)d_in[15]; a.w_down = (const float*)d_in[16]; a.g_final = (const float*)d_in[17];
    a.out = (float*)d_out; a.ws = (unsigned char*)d_ws;
    if (MK_N_LAUNCHES == 1) {
        a.ph_lo = 0; a.ph_hi = N_PHASES;
        void* kargs[] = {&a};
        hipError_t e = hipLaunchCooperativeKernel((const void*)fwd_kernel, dim3(grid), dim3(NWAVES * 64), kargs, LDS_BYTES, stream);
        if (e != hipSuccess) fprintf(stderr, "kernel_launch: cooperative launch failed: %s (grid %d)\n", hipGetErrorString(e), grid);
    } else {
        for (int p = 0; p < N_PHASES; ++p) {
            a.ph_lo = p; a.ph_hi = p + 1;
            hipLaunchKernelGGL(fwd_kernel, dim3(grid), dim3(NWAVES * 64), LDS_BYTES, stream, a);
        }
    }
}
```

```cpp
#include <hip/hip_runtime.h>
#include <cstdio>
#include <cstdint>

#ifndef MK_N_LAUNCHES
#define MK_N_LAUNCHES 1
#endif

#define LAS __attribute__((address_space(3)))
#define GAS __attribute__((address_space(1)))
typedef unsigned short bf16_t;
typedef short bf16x8 __attribute__((ext_vector_type(8)));
typedef float f32x4 __attribute__((ext_vector_type(4)));
typedef unsigned u32x4 __attribute__((ext_vector_type(4)));
typedef unsigned u32x2 __attribute__((ext_vector_type(2)));

constexpr int D = 2048, DC = 1024, DA = 1024, DKV = 256, NIN = 8704, FF = 5632, NGU = 2 * FF;
constexpr int MP = 8192, MS = 1024, M = MP + MS;
constexpr int SEQ = 2048, NBATCH = 4, DBATCH = 128, DSEQ = 8, WIN = 128;
constexpr float EPS = 1e-6f;
constexpr size_t OUT_Y = 0, OUT_KP = (size_t)M * D, OUT_VP = OUT_KP + 131072, OUT_CP = OUT_VP + 131072, OUT_KS = OUT_CP + 8192,
                 OUT_VS = OUT_KS + 4194304, OUT_CS = OUT_VS + 4194304, OUT_END = OUT_CS + 262144;
constexpr size_t MiB = 1u << 20;
constexpr size_t WS_CTL = 0, CTL_ZERO_BYTES = 1 * MiB;
constexpr size_t WS_WIN = 1 * MiB, WS_WC = 35 * MiB, WS_WA = 39 * MiB, WS_WO = 43 * MiB, WS_WGU = 51 * MiB, WS_WD = 95 * MiB;
constexpr size_t WS_XN = 117 * MiB, WS_ACONV = WS_XN, WS_ATT = WS_XN + 18 * MiB;
constexpr size_t WS_BG = 153 * MiB, WS_U = 171 * MiB, WS_Q = 189 * MiB, WS_K = 207 * MiB, WS_V = WS_K + (size_t)M * DKV * 2;
constexpr size_t WS_SG1 = 216 * MiB, WS_SG2 = 252 * MiB;
constexpr size_t WS_ACT1 = WS_BG;
constexpr size_t WS_ACT2 = 288 * MiB;
constexpr size_t WS_END = 288 * MiB + (size_t)14 * 256 * FF * 2;
static_assert(WS_V + (size_t)M * DKV * 2 == 216 * MiB && WS_ACT1 + (size_t)22 * 256 * FF * 2 <= 216 * MiB, "ws map");
constexpr int CW_BAR = 4096;
constexpr int CW_ROWSS = 32768;
constexpr int CW_CNT = 16384;
constexpr int CW_TMO = 8;

constexpr int RING_BYTES = 131072;
constexpr int LDSCTL_OFF = RING_BYTES, MISC_OFF = LDSCTL_OFF + 320;
constexpr int LDS_BYTES = 147456;
constexpr int NWAVES = 8;

#define LDS_WAIT() asm volatile("s_waitcnt lgkmcnt(0)" ::: "memory")
#define VM_WAIT() asm volatile("s_waitcnt vmcnt(0)" ::: "memory")
typedef float f32x2_t __attribute__((ext_vector_type(2))); typedef __bf16 bf16x2_t __attribute__((ext_vector_type(2)));
__device__ __forceinline__ unsigned cvt_pk_bf16(float lo, float hi) { const f32x2_t v = {lo, hi}; const bf16x2_t b = __builtin_convertvector(v, bf16x2_t); return __builtin_bit_cast(unsigned, b); }
__device__ __forceinline__ float bf_lo(unsigned w) { return __builtin_bit_cast(float, w << 16); }
__device__ __forceinline__ float bf_hi(unsigned w) { return __builtin_bit_cast(float, w & 0xffff0000u); }
__device__ __forceinline__ float fsigmoid(float x) { return __builtin_amdgcn_rcpf(1.0f + __expf(-x)); }
__device__ __forceinline__ float wave_sum(float v) {
#pragma unroll
    for (int o = 1; o < 64; o <<= 1) v += __shfl_xor(v, o);
    return v;
}

namespace pg8 {
constexpr int BM = 256, BK = 64, HALF = 128, HTB = HALF * BK * 2, STAGE_BYTES = 8 * HTB, NXCD = 8, WGM = 8;
__host__ __device__ __forceinline__ int lds_byte(int r, int c) { const int st = (r >> 4) * 2 + (c >> 5), rr = r & 15, cc = c & 31, ob = rr * 64 + cc * 2; return st * 1024 + (ob ^ (((ob >> 9) & 1) << 5)); }
__host__ __device__ __forceinline__ void stage_rc(int b, int& R, int& C) { const int st = b / 1024, sb = b % 1024, swz = sb ^ (((sb >> 9) & 1) << 5); R = (st >> 1) * 16 + swz / 64; C = (st & 1) * 32 + (swz % 64) / 2; }
__host__ __device__ __forceinline__ int perm32(int rho) { const int n = rho >> 4, i = rho & 15; return 8 * (i >> 2) + 4 * n + (i & 3); }

struct Unit { int pm, pn, aux; };
struct OrderMap {
    int nM, nN, nwg, G, c;
    __device__ __forceinline__ void init(int nM_, int nN_, int G_, int c_) { nM = nM_; nN = nN_; nwg = nM * nN; G = G_; c = c_; }
    __device__ __forceinline__ bool tile(int i, int& pm, int& pn) const {
        const long L = (long)i * G + c; if (L >= nwg) return false;
        int wgid = (int)L; { const int q = nwg / NXCD, r = nwg % NXCD, xcd = wgid % NXCD, off = wgid / NXCD; wgid = (xcd < r ? xcd * (q + 1) : r * (q + 1) + (xcd - r) * q) + off; }
        const int nig = WGM * nN, gid = wgid / nig, fm = gid * WGM, gsz = (nM - fm) < WGM ? (nM - fm) : WGM;
        pm = fm + ((wgid % nig) % gsz); pn = (wgid % nig) / gsz; return true;
    }
};
struct SchedG {
    OrderMap o; const char* A; const char* B; size_t tstep;
    __device__ __forceinline__ bool next(int i, Unit& u) const { u.aux = 0; return o.tile(i, u.pm, u.pn); }
    __device__ __forceinline__ const char* a_ptr(const Unit& u) const { return A + (size_t)u.pm * tstep; }
    __device__ __forceinline__ const char* b_ptr(const Unit& u) const { return B + (size_t)u.pn * tstep; }
};
struct SchedMix {
    OrderMap o; const char *A0, *A1, *B0, *B1; size_t tstep;
    __device__ __forceinline__ bool next(int i, Unit& u) const { u.aux = i & 1; return o.tile(i >> 1, u.pm, u.pn); }
    __device__ __forceinline__ const char* a_ptr(const Unit& u) const { return (u.aux ? A1 : A0) + (size_t)u.pm * tstep; }
    __device__ __forceinline__ const char* b_ptr(const Unit& u) const { return (u.aux ? B1 : B0) + (size_t)u.pn * tstep; }
};

template <class Epi, class Sched>
__device__ __forceinline__ void gemm_phase(LAS unsigned char* lds, const int K, const Sched& S, const Epi& E) {
    const int tid = threadIdx.x, wid = __builtin_amdgcn_readfirstlane(tid >> 6), lane = tid & 63, wr = wid >> 2, wc = wid & 3, fr = lane & 15, fq = lane >> 4;
    const int nt = K / BK;
    unsigned voffA[2], voffB[2];
#pragma unroll
    for (int i = 0; i < 2; ++i) { int R, C; stage_rc(tid * 16 + i * 8192, R, C); const int Rb = (R & ~31) + perm32(R & 31);
        voffA[i] = (unsigned)(R * K + C) * 2u; voffB[i] = (unsigned)(Rb * K + C) * 2u; }
    const size_t kstep = (size_t)(BK * 2);
    const size_t hstep = (size_t)HALF * K * 2;
    const unsigned ldsw = (unsigned)wid * 1024u;
    const int aoff = lds_byte(wr * 64 + fr, fq * 8), boff = lds_byte(wc * 32 + fr, fq * 8);
#define PG8_SA(b, h) (((b) * 2 + (h)) * HTB)
#define PG8_SB(b, h) ((4 + (b) * 2 + (h)) * HTB)
#define PG8_STAGE(bufoff, gbase, voff) do { _Pragma("unroll") for (int _i = 0; _i < 2; ++_i) \
        __builtin_amdgcn_global_load_lds((const unsigned*)((const char*)(gbase) + (voff)[_i]), (LAS unsigned*)(lds + (bufoff) + ldsw + _i * 8192), 16, 0, 0); } while (0)
#define PG8_LDA(dst, b, h) do { _Pragma("unroll") for (int m = 0; m < 4; ++m) _Pragma("unroll") for (int k = 0; k < 2; ++k) dst[m][k] = *(const LAS bf16x8*)(lds + PG8_SA(b, h) + aoff + m * 2048 + k * 1024); } while (0)
#define PG8_LDB(dst, b, h) do { _Pragma("unroll") for (int n = 0; n < 2; ++n) _Pragma("unroll") for (int k = 0; k < 2; ++k) dst[n][k] = *(const LAS bf16x8*)(lds + PG8_SB(b, h) + boff + n * 2048 + k * 1024); } while (0)
#define PG8_MMA(ai, bj, At, Bt) do { __builtin_amdgcn_s_setprio(1); _Pragma("unroll") for (int m = 0; m < 4; ++m) _Pragma("unroll") for (int n = 0; n < 2; ++n) _Pragma("unroll") for (int k = 0; k < 2; ++k) \
        acc[ai][bj][m][n] = __builtin_amdgcn_mfma_f32_16x16x32_bf16(Bt[n][k], At[m][k], acc[ai][bj][m][n], 0, 0, 0); __builtin_amdgcn_s_setprio(0); } while (0)
#define PG8_WAIT_V(n) asm volatile("s_waitcnt vmcnt(" #n ")" ::: "memory")
#define PG8_WAIT_L(n) asm volatile("s_waitcnt lgkmcnt(" #n ")" ::: "memory")
#define PG8_BAR __builtin_amdgcn_s_barrier()
#define PG8_SCHED __builtin_amdgcn_sched_barrier(0)
    Unit cur, nxt; int ui = 0;
    if (!S.next(0, cur)) return;
    f32x4 acc[2][2][4][2];
#pragma unroll
    for (int a = 0; a < 2; ++a)
#pragma unroll
        for (int b = 0; b < 2; ++b)
#pragma unroll
            for (int m = 0; m < 4; ++m)
#pragma unroll
                for (int n = 0; n < 2; ++n) acc[a][b][m][n] = (f32x4){0.f, 0.f, 0.f, 0.f};
    bf16x8 At[4][2], B0[2][2], B1[2][2];
    const char* cA = S.a_ptr(cur); const char* cB = S.b_ptr(cur);
    PG8_STAGE(PG8_SB(0, 0), cB, voffB); PG8_STAGE(PG8_SB(0, 1), cB + hstep, voffB); PG8_STAGE(PG8_SA(0, 0), cA, voffA); PG8_STAGE(PG8_SA(0, 1), cA + hstep, voffA);
    if (wr == 1) PG8_BAR;
    PG8_WAIT_V(2); PG8_BAR;
    PG8_STAGE(PG8_SB(1, 0), cB + kstep, voffB); PG8_STAGE(PG8_SA(1, 0), cA + kstep, voffA); PG8_STAGE(PG8_SB(1, 1), cB + hstep + kstep, voffB);
    PG8_WAIT_V(6); PG8_BAR;
    for (;;) {
        const bool has_next = S.next(ui + 1, nxt);
        const char* nA = has_next ? S.a_ptr(nxt) : cA; const char* nB = has_next ? S.b_ptr(nxt) : cB;
        for (int t = 0; t < nt; t += 2) {
            const bool last = (t == nt - 2);
            const char* a1 = cA + (size_t)(t + 1) * kstep;
            const char* a2 = last ? nA : cA + (size_t)(t + 2) * kstep; const char* b2 = last ? nB : cB + (size_t)(t + 2) * kstep;
            const char* a3 = a2 + kstep; const char* b3 = b2 + kstep;
            PG8_LDB(B0, 0, 0); PG8_LDB(B1, 0, 1); PG8_SCHED; PG8_LDA(At, 0, 0); PG8_STAGE(PG8_SA(1, 1), a1 + hstep, voffA);
            PG8_WAIT_V(8); PG8_WAIT_L(0); PG8_BAR; PG8_MMA(0, 0, At, B0); PG8_MMA(0, 1, At, B1); PG8_BAR; PG8_SCHED;
            PG8_LDA(At, 0, 1); PG8_STAGE(PG8_SB(0, 0), b2, voffB); PG8_STAGE(PG8_SB(0, 1), b2 + hstep, voffB); PG8_STAGE(PG8_SA(0, 0), a2, voffA);
            PG8_WAIT_V(8); PG8_WAIT_L(0); PG8_BAR; PG8_MMA(1, 0, At, B0); PG8_MMA(1, 1, At, B1); PG8_BAR; PG8_SCHED;
            PG8_LDB(B0, 1, 0); PG8_LDB(B1, 1, 1); PG8_SCHED; PG8_LDA(At, 1, 0); PG8_STAGE(PG8_SA(0, 1), a2 + hstep, voffA);
            PG8_WAIT_V(8); PG8_WAIT_L(0); PG8_BAR; PG8_MMA(0, 0, At, B0); PG8_MMA(0, 1, At, B1); PG8_BAR; PG8_SCHED;
            PG8_LDA(At, 1, 1); PG8_STAGE(PG8_SB(1, 0), b3, voffB); PG8_STAGE(PG8_SB(1, 1), b3 + hstep, voffB); PG8_STAGE(PG8_SA(1, 0), a3, voffA);
            PG8_WAIT_V(8); PG8_WAIT_L(0); PG8_BAR; PG8_MMA(1, 0, At, B0); PG8_MMA(1, 1, At, B1); PG8_BAR; PG8_SCHED;
        }
        if (wr == 0) PG8_BAR;
        E(acc, cur, wr, wc, fr, fq);
        if (!has_next) break;
        if (!E.keep(cur)) {
#pragma unroll
            for (int a = 0; a < 2; ++a)
#pragma unroll
                for (int b = 0; b < 2; ++b)
#pragma unroll
                    for (int m = 0; m < 4; ++m)
#pragma unroll
                        for (int n = 0; n < 2; ++n) acc[a][b][m][n] = (f32x4){0.f, 0.f, 0.f, 0.f};
        }
        cur = nxt; cA = nA; cB = nB; ++ui;
        if (wr == 1) PG8_BAR;
    }
    PG8_WAIT_V(0);
    PG8_BAR;
#undef PG8_SA
#undef PG8_SB
#undef PG8_STAGE
#undef PG8_LDA
#undef PG8_LDB
#undef PG8_MMA
#undef PG8_WAIT_V
#undef PG8_WAIT_L
#undef PG8_BAR
#undef PG8_SCHED
}

__device__ __forceinline__ u32x4 pack8(const f32x4 v0, const f32x4 v1) { u32x4 w; w.x = cvt_pk_bf16(v0[0], v0[1]); w.y = cvt_pk_bf16(v0[2], v0[3]); w.z = cvt_pk_bf16(v1[0], v1[1]); w.w = cvt_pk_bf16(v1[2], v1[3]); return w; }
__device__ __forceinline__ void unpack8(const u32x4 w, f32x4& v0, f32x4& v1) { v0 = (f32x4){bf_lo(w.x), bf_hi(w.x), bf_lo(w.y), bf_hi(w.y)}; v1 = (f32x4){bf_lo(w.z), bf_hi(w.z), bf_lo(w.w), bf_hi(w.w)}; }

struct EpiIn {
    bf16_t *Bg, *U, *Q, *Kb, *Vb, *SG1, *SG2; float* out;
    __device__ __forceinline__ bool keep(const Unit&) const { return false; }
    __device__ __forceinline__ void operator()(f32x4 (&acc)[2][2][4][2], const Unit& u, int wr, int wc, int fr, int fq) const {
        const int pn = u.pn, row0 = u.pm * BM + wr * 64 + fr, cl = wc * 32 + 8 * fq;
        if (pn >= 4 && pn < 12) {
            const int ch = 128 * (pn - 4) + cl;
#pragma unroll
            for (int ai = 0; ai < 2; ++ai)
#pragma unroll
                for (int m = 0; m < 4; ++m) {
                    const int row = row0 + ai * HALF + m * 16;
                    const f32x4 u0 = acc[ai][0][m][0] * acc[ai][1][m][0], u1 = acc[ai][0][m][1] * acc[ai][1][m][1];
                    *(u32x4*)(U + (size_t)row * DC + ch) = pack8(u0, u1);
                    bool st; size_t idx;
                    if (row < MP) { const int t = row & (SEQ - 1); st = t >= SEQ - 2; idx = OUT_CP + (size_t)((row >> 11) * 2 + (t - (SEQ - 2))) * DC + ch; }
                    else { const int s = row - MP, t = s & 7; st = t >= 6; idx = OUT_CS + (size_t)((s >> 3) * 2 + (t - 6)) * DC + ch; }
                    if (st) { *(f32x4*)(out + idx) = u0; *(f32x4*)(out + idx + 4) = u1; }
                }
            return;
        }
        bf16_t* dst; int ld, col0; float sc = 1.f; bool sig = false; int side = 0;
        if (pn < 4) { dst = Bg; ld = DC; col0 = 256 * pn; }
        else if (pn < 16) { dst = Q; ld = DA; col0 = 256 * (pn - 12); sc = 0.125f; }
        else if (pn == 16) { dst = Kb; ld = DKV; col0 = 0; side = 1; }
        else if (pn == 17) { dst = Vb; ld = DKV; col0 = 0; side = 2; }
        else if (pn < 26) { dst = SG1; ld = D; col0 = 256 * (pn - 18); sig = true; }
        else { dst = SG2; ld = D; col0 = 256 * (pn - 26); sig = true; }
#pragma unroll
        for (int ai = 0; ai < 2; ++ai)
#pragma unroll
            for (int m = 0; m < 4; ++m) {
                const int row = row0 + ai * HALF + m * 16;
                bool st = false; size_t sidx = 0;
                if (side) {
                    if (row < MP) { const int t = row & (SEQ - 1); st = t >= SEQ - WIN; sidx = (side == 1 ? OUT_KP : OUT_VP) + (size_t)((row >> 11) * WIN + (t - (SEQ - WIN))) * DKV; }
                    else { const int s = row - MP; st = true; sidx = (side == 1 ? OUT_KS : OUT_VS) + (size_t)((s >> 3) * WIN + (WIN - DSEQ) + (s & 7)) * DKV; }
                }
#pragma unroll
                for (int bj = 0; bj < 2; ++bj) {
                    f32x4 v0 = acc[ai][bj][m][0], v1 = acc[ai][bj][m][1];
                    if (st) { *(f32x4*)(out + sidx + bj * HALF + cl) = v0; *(f32x4*)(out + sidx + bj * HALF + cl + 4) = v1; }
                    if (sig) {
#pragma unroll
                        for (int j = 0; j < 4; ++j) { v0[j] = fsigmoid(v0[j]); v1[j] = fsigmoid(v1[j]); }
                    } else { v0 = v0 * sc; v1 = v1 * sc; }
                    *(u32x4*)(dst + (size_t)row * ld + col0 + bj * HALF + cl) = pack8(v0, v1);
                }
            }
    }
};
enum { K_MIX0 = 0, K_MIX1 = 1, K_WO = 2, K_GU = 3, K_DN0 = 4, K_DN1 = 5 };
struct SU { int kind, pm, pn; };
struct SParams { const char* a; const char* b; int nt; unsigned pitch2; unsigned* dep; unsigned need; unsigned* pub; };
struct StreamCtx {
    const char *ACONV, *ATT, *WC, *WA, *MERGED, *WO, *HB, *WGU, *ACT1, *ACT2, *WD; unsigned* cnt;
};
constexpr int ACT_SPLIT_PM = 22;
constexpr int CNT_MIX = 0, CNT_WO = 1, CNT_GU = 2;
struct StreamSched {
    int x, r; StreamCtx c;
    __device__ __forceinline__ static void tile8(int x, int t, int& pm, int& pn) {
        if (t < 32) { pm = x + 8 * (t & 3); pn = t >> 2; } else { const int s = 4 * x + (t - 32); pm = 32 + (s >> 3); pn = s & 7; } }
    __device__ __forceinline__ bool next(int k, SU& u) const {
        const int nmix = (r < 4) ? 2 : 1;
        int e, aux = 0;
        if (k < 2 * nmix) { e = r + 32 * (k >> 1); aux = k & 1; } else e = r + 32 * (k - nmix);
        if (e >= 342) return false;
        if (e < 36) { u.kind = aux ? K_MIX1 : K_MIX0; tile8(x, e, u.pm, u.pn); }
        else if (e < 72) { u.kind = K_WO; tile8(x, e - 36, u.pm, u.pn); }
        else if (e < 270) { const int q = e - 72; u.kind = K_GU;
            if (q < 160) { const int w = q & 31; u.pm = x + 8 * (w & 3); u.pn = 8 * (q >> 5) + (w >> 2); }
            else if (q < 176) { const int w = q - 160; u.pm = x + 8 * (w & 3); u.pn = 40 + (w >> 2); }
            else { const int sidx = 22 * x + (q - 176); u.pm = 32 + sidx / 44; u.pn = sidx % 44; } }
        else { const int q = e - 270; u.kind = (q & 1) ? K_DN1 : K_DN0; tile8(x, q >> 1, u.pm, u.pn); }
        return true;
    }
    __device__ __forceinline__ void params(const SU& u, SParams& p) const {
        p.dep = nullptr; p.need = 0; p.pub = nullptr;
        switch (u.kind) {
        case K_MIX0: p.a = c.ACONV + (size_t)u.pm * (256 * DC * 2); p.b = c.WC + (size_t)u.pn * (256 * DC * 2); p.nt = DC / 64; p.pitch2 = DC * 2; break;
        case K_MIX1: p.a = c.ATT + (size_t)u.pm * (256 * DA * 2); p.b = c.WA + (size_t)u.pn * (256 * DA * 2); p.nt = DA / 64; p.pitch2 = DA * 2; p.pub = c.cnt + (CNT_MIX * 36 + u.pm) * 64; break;
        case K_WO: p.a = c.MERGED + (size_t)u.pm * (256 * D * 2); p.b = c.WO + (size_t)u.pn * (256 * D * 2); p.nt = D / 64; p.pitch2 = D * 2;
            p.dep = c.cnt + (CNT_MIX * 36 + u.pm) * 64; p.need = 64; p.pub = c.cnt + (CNT_WO * 36 + u.pm) * 64; break;
        case K_GU: p.a = c.HB + (size_t)u.pm * (256 * D * 2); p.b = c.WGU + (size_t)u.pn * (256 * D * 2); p.nt = D / 64; p.pitch2 = D * 2;
            p.dep = c.cnt + (CNT_WO * 36 + u.pm) * 64; p.need = 64; p.pub = c.cnt + (CNT_GU * 36 + u.pm) * 64; break;
        default: { const int h = (u.kind == K_DN1);
            p.a = (u.pm < ACT_SPLIT_PM ? c.ACT1 + (size_t)u.pm * (256 * FF * 2) : c.ACT2 + (size_t)(u.pm - ACT_SPLIT_PM) * (256 * FF * 2)) + h * (FF);
            p.b = c.WD + (size_t)u.pn * (256 * FF * 2) + h * (FF); p.nt = FF / 128; p.pitch2 = FF * 2;
            p.dep = c.cnt + (CNT_GU * 36 + u.pm) * 64; p.need = 352; } break;
        }
    }
};
__device__ __forceinline__ bool stream_poll_once(unsigned* dep, unsigned need) {
    const bool ok = (unsigned)__builtin_amdgcn_readfirstlane(__hip_atomic_load(dep, __ATOMIC_RELAXED, __HIP_MEMORY_SCOPE_AGENT)) >= need;
    if (ok) { __builtin_amdgcn_fence(__ATOMIC_ACQUIRE, "agent"); asm volatile("s_waitcnt vmcnt(0)" ::: "memory"); }
    return ok;
}
__device__ __forceinline__ void stream_poll_block(unsigned* dep, unsigned need, unsigned* tmo) {
    unsigned spins = 0;
    while ((unsigned)__builtin_amdgcn_readfirstlane(__hip_atomic_load(dep, __ATOMIC_RELAXED, __HIP_MEMORY_SCOPE_AGENT)) < need) {
        __builtin_amdgcn_s_sleep(2);
        if ((++spins & 1023u) == 0u) { if (__hip_atomic_load(tmo, __ATOMIC_RELAXED, __HIP_MEMORY_SCOPE_AGENT) != 0u) break; if (spins > (1u << 21)) { __hip_atomic_store(tmo, 1u, __ATOMIC_RELAXED, __HIP_MEMORY_SCOPE_AGENT); break; } }
    }
    __builtin_amdgcn_fence(__ATOMIC_ACQUIRE, "agent"); asm volatile("s_waitcnt vmcnt(0)" ::: "memory");
}
__device__ __forceinline__ __amdgpu_buffer_rsrc_t mk_rsrc(const void* p) { return __builtin_amdgcn_make_buffer_rsrc(const_cast<void*>(p), 0, 0x7fffffff, 0x00020000); }
__device__ __forceinline__ void st16_wt(__amdgpu_buffer_rsrc_t rs, unsigned off, u32x4 v) { __builtin_amdgcn_raw_buffer_store_b128(v, rs, off, 0, 16); }

struct EpiStream {
    bf16_t *SG1, *SG2;
    const float *xp, *xs; float* H; float* rowss; bf16_t *ACT1, *ACT2;
    __device__ __forceinline__ bool keep(const SU& u) const { return u.kind == K_MIX0; }
    __device__ __forceinline__ void operator()(f32x4 (&acc)[2][2][4][2], const SU& u, int wr, int wc, int fr, int fq) const {
        const int row0 = u.pm * BM + wr * 64 + fr, cl = wc * 32 + 8 * fq;
        if (u.kind == K_MIX0) {
            const size_t o0 = (size_t)row0 * D + u.pn * BM + cl; const bf16_t* g2 = SG2 + o0; const bf16_t* g1 = SG1 + o0;
#pragma unroll
            for (int s = 0; s < 8; ++s) { const int ai = s >> 2, m = s & 3; const size_t off = (size_t)(ai * HALF + m * 16) * D;
#pragma unroll
                for (int bj = 0; bj < 2; ++bj) {
                    f32x4 a0, a1, c0, c1; unpack8(*(const u32x4*)(g2 + off + bj * HALF), a0, a1); unpack8(*(const u32x4*)(g1 + off + bj * HALF), c0, c1);
#pragma unroll
                    for (int j = 0; j < 4; ++j) { acc[ai][bj][m][0][j] *= c0[j] * __builtin_amdgcn_rcpf(fmaxf(a0[j], 1e-30f)); acc[ai][bj][m][1][j] *= c1[j] * __builtin_amdgcn_rcpf(fmaxf(a1[j], 1e-30f)); }
                } }
        } else if (u.kind == K_MIX1) {
            const size_t o0 = (size_t)row0 * D + u.pn * BM + cl; const bf16_t* g2 = SG2 + o0;
            const __amdgpu_buffer_rsrc_t rs = mk_rsrc(SG1); const unsigned ob = (unsigned)o0 * 2u;
            u32x4 gv[2][2];
            gv[0][0] = *(const u32x4*)(g2); gv[0][1] = *(const u32x4*)(g2 + HALF);
#pragma unroll
            for (int s = 0; s < 8; ++s) { const int ai = s >> 2, m = s & 3; const unsigned off = (unsigned)(ai * HALF + m * 16) * D;
                if (s + 1 < 8) { const size_t off2 = (size_t)(((s + 1) >> 2) * HALF + ((s + 1) & 3) * 16) * D;
                    gv[(s + 1) & 1][0] = *(const u32x4*)(g2 + off2); gv[(s + 1) & 1][1] = *(const u32x4*)(g2 + off2 + HALF); }
#pragma unroll
                for (int bj = 0; bj < 2; ++bj) { f32x4 a0, a1; unpack8(gv[s & 1][bj], a0, a1);
                    st16_wt(rs, ob + (off + bj * HALF) * 2u, pack8(acc[ai][bj][m][0] * a0, acc[ai][bj][m][1] * a1)); }
            }
        } else if (u.kind == K_WO) {
            const size_t o0 = (size_t)row0 * D + u.pn * BM + cl;
            const float* xb = ((u.pm < MP / BM) ? xp : xs - (size_t)MP * D) + o0;
            const __amdgpu_buffer_rsrc_t rb = mk_rsrc(SG2); const unsigned obf = (unsigned)o0 * 2u;
            float* rsum = rowss + row0;
            f32x4 xv[2][4];
#define WO_LD(s_, buf_) do { const size_t o_ = (size_t)(((s_) >> 2) * HALF + ((s_) & 3) * 16) * D; \
            xv[buf_][0] = *(const f32x4*)(xb + o_); xv[buf_][1] = *(const f32x4*)(xb + o_ + 4); xv[buf_][2] = *(const f32x4*)(xb + o_ + HALF); xv[buf_][3] = *(const f32x4*)(xb + o_ + HALF + 4); } while (0)
            WO_LD(0, 0);
#pragma unroll
            for (int s = 0; s < 8; ++s) { const int ai = s >> 2, m = s & 3; const unsigned off = (unsigned)(ai * HALF + m * 16) * D;
                if (s + 1 < 8) WO_LD(s + 1, (s + 1) & 1);
                const f32x4 h00 = xv[s & 1][0] + acc[ai][0][m][0], h01 = xv[s & 1][1] + acc[ai][0][m][1], h10 = xv[s & 1][2] + acc[ai][1][m][0], h11 = xv[s & 1][3] + acc[ai][1][m][1];
                st16_wt(rb, obf + off * 2u, pack8(h00, h01)); st16_wt(rb, obf + (off + HALF) * 2u, pack8(h10, h11));
                float ss = (h00[0] * h00[0] + h00[1] * h00[1]) + (h00[2] * h00[2] + h00[3] * h00[3]) + (h01[0] * h01[0] + h01[1] * h01[1]) + (h01[2] * h01[2] + h01[3] * h01[3])
                         + (h10[0] * h10[0] + h10[1] * h10[1]) + (h10[2] * h10[2] + h10[3] * h10[3]) + (h11[0] * h11[0] + h11[1] * h11[1]) + (h11[2] * h11[2] + h11[3] * h11[3]);
                ss += __shfl_xor(ss, 16); ss += __shfl_xor(ss, 32);
                if (fq == 0) __hip_atomic_fetch_add(rsum + ai * HALF + m * 16, ss, __ATOMIC_RELAXED, __HIP_MEMORY_SCOPE_AGENT);
            }
#undef WO_LD
        } else if (u.kind == K_GU) {
            const int ch = 128 * u.pn + cl;
            float rstd[8];
#pragma unroll
            for (int s = 0; s < 8; ++s) rstd[s] = __hip_atomic_load(rowss + row0 + (s >> 2) * HALF + (s & 3) * 16, __ATOMIC_RELAXED, __HIP_MEMORY_SCOPE_AGENT);
#pragma unroll
            for (int s = 0; s < 8; ++s) rstd[s] = __builtin_amdgcn_rsqf(rstd[s] * (1.0f / D) + EPS);
            const bool lo = u.pm < ACT_SPLIT_PM;
            const __amdgpu_buffer_rsrc_t ra = mk_rsrc(lo ? ACT1 : ACT2);
            const unsigned oa = (unsigned)(((size_t)(row0 - (lo ? 0 : ACT_SPLIT_PM * BM)) * FF + ch) * 2);
#pragma unroll
            for (int s = 0; s < 8; ++s) { const int ai = s >> 2, m = s & 3; const float rr = rstd[s];
                f32x4 o[2];
#pragma unroll
                for (int n = 0; n < 2; ++n)
#pragma unroll
                    for (int j = 0; j < 4; ++j) { const float g = acc[ai][0][m][n][j] * rr, up = acc[ai][1][m][n][j] * rr; o[n][j] = g * fsigmoid(g) * up; }
                st16_wt(ra, oa + (unsigned)(ai * HALF + m * 16) * (FF * 2), pack8(o[0], o[1]));
            }
        } else if (u.kind == K_DN0) {
            const size_t o0 = (size_t)row0 * D + u.pn * BM + cl;
            const bf16_t* hb = SG2 + o0; float* hp = H + o0;
            u32x4 hv[2][2];
            hv[0][0] = *(const u32x4*)(hb); hv[0][1] = *(const u32x4*)(hb + HALF);
#pragma unroll
            for (int s = 0; s < 8; ++s) { const int ai = s >> 2, m = s & 3; const size_t off = (size_t)(ai * HALF + m * 16) * D;
                if (s + 1 < 8) { const size_t off2 = (size_t)(((s + 1) >> 2) * HALF + ((s + 1) & 3) * 16) * D;
                    hv[(s + 1) & 1][0] = *(const u32x4*)(hb + off2); hv[(s + 1) & 1][1] = *(const u32x4*)(hb + off2 + HALF); }
#pragma unroll
                for (int bj = 0; bj < 2; ++bj) { f32x4 a0, a1; unpack8(hv[s & 1][bj], a0, a1);
                    *(f32x4*)(hp + off + bj * HALF) = a0 + acc[ai][bj][m][0]; *(f32x4*)(hp + off + bj * HALF + 4) = a1 + acc[ai][bj][m][1]; }
            }
        } else {
            bf16_t* pb = SG1 + (size_t)row0 * D + u.pn * BM + cl;
#pragma unroll
            for (int s = 0; s < 8; ++s) { const int ai = s >> 2, m = s & 3; const size_t off = (size_t)(ai * HALF + m * 16) * D;
#pragma unroll
                for (int bj = 0; bj < 2; ++bj) *(u32x4*)(pb + off + bj * HALF) = pack8(acc[ai][bj][m][0], acc[ai][bj][m][1]); }
        }
    }
};

template <class Epi, class Sched>
__device__ __forceinline__ void gemm_stream(LAS unsigned char* lds, volatile LAS unsigned* flagw, const Sched& S, const Epi& E, unsigned* tmo) {
    const int tid = threadIdx.x, wid = __builtin_amdgcn_readfirstlane(tid >> 6), lane = tid & 63, wr = wid >> 2, wc = wid & 3, fr = lane & 15, fq = lane >> 4;
    int R0, C0; stage_rc(tid * 16, R0, C0); const int Rb0 = (R0 & ~31) + perm32(R0 & 31);
    const size_t kstep = (size_t)(BK * 2);
    const unsigned ldsw = (unsigned)wid * 1024u;
    const int aoff = lds_byte(wr * 64 + fr, fq * 8), boff = lds_byte(wc * 32 + fr, fq * 8);
#define PG8_SA(b, h) (((b) * 2 + (h)) * HTB)
#define PG8_SB(b, h) ((4 + (b) * 2 + (h)) * HTB)
#define PG8_STAGE(bufoff, gbase, voff, rstep) do { \
        __builtin_amdgcn_global_load_lds((const unsigned*)((const char*)(gbase) + (voff)), (LAS unsigned*)(lds + (bufoff) + ldsw), 16, 0, 0); \
        __builtin_amdgcn_global_load_lds((const unsigned*)((const char*)(gbase) + (rstep) + (voff)), (LAS unsigned*)(lds + (bufoff) + ldsw + 8192), 16, 0, 0); } while (0)
#define PG8_LDA(dst, b, h) do { _Pragma("unroll") for (int m = 0; m < 4; ++m) _Pragma("unroll") for (int k = 0; k < 2; ++k) dst[m][k] = *(const LAS bf16x8*)(lds + PG8_SA(b, h) + aoff + m * 2048 + k * 1024); } while (0)
#define PG8_LDB(dst, b, h) do { _Pragma("unroll") for (int n = 0; n < 2; ++n) _Pragma("unroll") for (int k = 0; k < 2; ++k) dst[n][k] = *(const LAS bf16x8*)(lds + PG8_SB(b, h) + boff + n * 2048 + k * 1024); } while (0)
#define PG8_MMA(ai, bj, At, Bt) do { __builtin_amdgcn_s_setprio(1); _Pragma("unroll") for (int m = 0; m < 4; ++m) _Pragma("unroll") for (int n = 0; n < 2; ++n) _Pragma("unroll") for (int k = 0; k < 2; ++k) \
        acc[ai][bj][m][n] = __builtin_amdgcn_mfma_f32_16x16x32_bf16(Bt[n][k], At[m][k], acc[ai][bj][m][n], 0, 0, 0); __builtin_amdgcn_s_setprio(0); } while (0)
#define PG8_WAIT_V(n) asm volatile("s_waitcnt vmcnt(" #n ")" ::: "memory")
#define PG8_WAIT_L(n) asm volatile("s_waitcnt lgkmcnt(" #n ")" ::: "memory")
#define PG8_BAR __builtin_amdgcn_s_barrier()
#define PG8_SCHED __builtin_amdgcn_sched_barrier(0)
#define PG8_ZERO_ACC() do { _Pragma("unroll") for (int a = 0; a < 2; ++a) _Pragma("unroll") for (int b = 0; b < 2; ++b) _Pragma("unroll") for (int m = 0; m < 4; ++m) _Pragma("unroll") for (int n = 0; n < 2; ++n) acc[a][b][m][n] = (f32x4){0.f, 0.f, 0.f, 0.f}; } while (0)
    SU cur, nxt; SParams pc, pq; int ui = 0;
    if (!S.next(0, cur)) return;
    S.params(cur, pc);
    f32x4 acc[2][2][4][2];
    PG8_ZERO_ACC();
    bf16x8 At[4][2], B0[2][2], B1[2][2];
    unsigned known0 = 0u, known1 = 0u, known2 = 0u, known3 = 0u;
#define PG8_KNOWN(idx) ((((idx) < 32 ? known0 : (idx) < 64 ? known1 : (idx) < 96 ? known2 : known3) >> ((idx) & 31)) & 1u)
#define PG8_SETKNOWN(idx) do { const unsigned b_ = 1u << ((idx) & 31); if ((idx) < 32) known0 |= b_; else if ((idx) < 64) known1 |= b_; else if ((idx) < 96) known2 |= b_; else known3 |= b_; } while (0)
    for (;;) {
        if (pc.dep) {
            const int didx = (int)(pc.dep - S.c.cnt) >> 6;
            if (!PG8_KNOWN(didx)) {
                if (wid == 0) stream_poll_block(pc.dep, pc.need, tmo);
                PG8_BAR;
                PG8_SETKNOWN(didx);
            }
        }
        const char* cA = pc.a; const char* cB = pc.b; int nt = pc.nt;
        unsigned vAc = (unsigned)R0 * pc.pitch2 + (unsigned)C0 * 2u, vBc = (unsigned)Rb0 * pc.pitch2 + (unsigned)C0 * 2u;
        size_t rsc = (size_t)64 * pc.pitch2, hsc = (size_t)HALF * pc.pitch2;
        unsigned* pend = nullptr;
        PG8_STAGE(PG8_SB(0, 0), cB, vBc, rsc); PG8_STAGE(PG8_SB(0, 1), cB + hsc, vBc, rsc); PG8_STAGE(PG8_SA(0, 0), cA, vAc, rsc); PG8_STAGE(PG8_SA(0, 1), cA + hsc, vAc, rsc);
        if (wr == 1) PG8_BAR;
        PG8_WAIT_V(2); PG8_BAR;
        PG8_STAGE(PG8_SB(1, 0), cB + kstep, vBc, rsc); PG8_STAGE(PG8_SA(1, 0), cA + kstep, vAc, rsc); PG8_STAGE(PG8_SB(1, 1), cB + hsc + kstep, vBc, rsc);
        PG8_WAIT_V(6); PG8_BAR;
        bool has_next, chain;
        for (;;) {
            has_next = S.next(ui + 1, nxt);
            if (has_next) S.params(nxt, pq); else pq = pc;
            chain = has_next;
            const char* nA = cA; const char* nB = cB; unsigned vAn = vAc, vBn = vBc; size_t rsn = rsc, hsn = hsc;
            for (int t = 0; t < nt; t += 2) {
                const bool last = (t == nt - 2);
                if (last && has_next) {
                    if (pq.dep) {
                        const int didx = (int)(pq.dep - S.c.cnt) >> 6;
                        if (!PG8_KNOWN(didx)) {
                            if (wid == 0) { const bool ok = stream_poll_once(pq.dep, pq.need); if (lane == 0) *flagw = ok ? 1u : 0u; asm volatile("s_waitcnt lgkmcnt(0)" ::: "memory"); }
                            PG8_BAR;
                            chain = (*flagw != 0u);
                            if (chain) PG8_SETKNOWN(didx);
                        }
                    }
                    if (chain) { nA = pq.a; nB = pq.b; vAn = (unsigned)R0 * pq.pitch2 + (unsigned)C0 * 2u; vBn = (unsigned)Rb0 * pq.pitch2 + (unsigned)C0 * 2u; rsn = (size_t)64 * pq.pitch2; hsn = (size_t)HALF * pq.pitch2; }
                }
                const char* a1 = cA + (size_t)(t + 1) * kstep;
                const char* a2 = last ? nA : cA + (size_t)(t + 2) * kstep; const char* b2 = last ? nB : cB + (size_t)(t + 2) * kstep;
                const char* a3 = a2 + kstep; const char* b3 = b2 + kstep;
                const unsigned vA2 = last ? vAn : vAc, vB2 = last ? vBn : vBc; const size_t rs2 = last ? rsn : rsc, hs2 = last ? hsn : hsc;
                PG8_LDB(B0, 0, 0); PG8_LDB(B1, 0, 1); PG8_SCHED; PG8_LDA(At, 0, 0); PG8_STAGE(PG8_SA(1, 1), a1 + hsc, vAc, rsc);
                PG8_WAIT_V(8); PG8_WAIT_L(0); PG8_BAR; PG8_MMA(0, 0, At, B0); PG8_MMA(0, 1, At, B1); PG8_BAR; PG8_SCHED;
                PG8_LDA(At, 0, 1); PG8_STAGE(PG8_SB(0, 0), b2, vB2, rs2); PG8_STAGE(PG8_SB(0, 1), b2 + hs2, vB2, rs2); PG8_STAGE(PG8_SA(0, 0), a2, vA2, rs2);
                PG8_WAIT_V(8); PG8_WAIT_L(0); PG8_BAR; PG8_MMA(1, 0, At, B0); PG8_MMA(1, 1, At, B1); PG8_BAR; PG8_SCHED;
                PG8_LDB(B0, 1, 0); PG8_LDB(B1, 1, 1); PG8_SCHED; PG8_LDA(At, 1, 0); PG8_STAGE(PG8_SA(0, 1), a2 + hs2, vA2, rs2);
                PG8_WAIT_V(8); PG8_WAIT_L(0); PG8_BAR; PG8_MMA(0, 0, At, B0); PG8_MMA(0, 1, At, B1); PG8_BAR; PG8_SCHED;
                PG8_LDA(At, 1, 1); PG8_STAGE(PG8_SB(1, 0), b3, vB2, rs2); PG8_STAGE(PG8_SB(1, 1), b3 + hs2, vB2, rs2); PG8_STAGE(PG8_SA(1, 0), a3, vA2, rs2);
                PG8_WAIT_V(8); PG8_WAIT_L(0); PG8_BAR; PG8_MMA(1, 0, At, B0); PG8_MMA(1, 1, At, B1); PG8_BAR; PG8_SCHED;
                if (t == 0 && pend) { if (lane == 0) __hip_atomic_fetch_add(pend, 1u, __ATOMIC_RELAXED, __HIP_MEMORY_SCOPE_AGENT); pend = nullptr; }
            }
            if (wr == 0) PG8_BAR;
            E(acc, cur, wr, wc, fr, fq);
            pend = pc.pub;
            if (!chain) break;
            if (!E.keep(cur)) PG8_ZERO_ACC();
            cur = nxt; pc = pq; cA = nA; cB = nB; nt = pc.nt; vAc = vAn; vBc = vBn; rsc = rsn; hsc = hsn; ++ui;
            if (wr == 1) PG8_BAR;
        }
        PG8_WAIT_V(0);
        if (pend && lane == 0) __hip_atomic_fetch_add(pend, 1u, __ATOMIC_RELAXED, __HIP_MEMORY_SCOPE_AGENT);
        PG8_BAR;
        if (!has_next) break;
        PG8_ZERO_ACC();
        cur = nxt; pc = pq; ++ui;
    }
#undef PG8_SA
#undef PG8_SB
#undef PG8_STAGE
#undef PG8_LDA
#undef PG8_LDB
#undef PG8_MMA
#undef PG8_WAIT_V
#undef PG8_WAIT_L
#undef PG8_BAR
#undef PG8_SCHED
#undef PG8_ZERO_ACC
#undef PG8_KNOWN
#undef PG8_SETKNOWN
}
}

#define XB_TMO      128
#define XB_XCNT(j)  (256  + 64 * (j))
#define XB_XSUB(j)  (1280 + 64 * (j))
#define XB_XGEN(j)  (2304 + 64 * (j))
#define XB_TOP      3328
#define XB_TOPGEN   3392
#define XCD_BAR_WORDS 3456
#define XB_SPIN_CAP (1u << 18)
__device__ __forceinline__ unsigned xb_ld(unsigned* p)              { return __hip_atomic_load(p, __ATOMIC_RELAXED, __HIP_MEMORY_SCOPE_AGENT); }
__device__ __forceinline__ unsigned xb_add(unsigned* p, unsigned v) { return __hip_atomic_fetch_add(p, v, __ATOMIC_RELAXED, __HIP_MEMORY_SCOPE_AGENT); }
__device__ __forceinline__ unsigned xb_xcc_id() { return (unsigned)__builtin_amdgcn_s_getreg((3 << 11) | 20) & 0xFu; }
#define XB_SPIN(cond, bar) do { unsigned _sp = 0; while (cond) { __builtin_amdgcn_s_sleep(1); \
    if ((++_sp & 255u) == 0u) { if (xb_ld(&(bar)[XB_TMO])) break; if (_sp > XB_SPIN_CAP) { atomicAdd(&(bar)[XB_TMO], 1u); break; } } } } while (0)
struct XcdBarrier { unsigned* bar; unsigned x; volatile LAS unsigned* st; };
__device__ __forceinline__ XcdBarrier xcd_barrier_post(unsigned* bar, volatile LAS unsigned* st) {
    XcdBarrier b; b.bar = bar; b.x = xb_xcc_id(); b.st = st;
    if (threadIdx.x == 0) (void)xb_add(&bar[XB_XCNT(b.x)], 1u);
    return b;
}
__device__ __forceinline__ void xcd_barrier_complete(unsigned* bar, unsigned x, unsigned& nloc, unsigned& nx) {
    const unsigned G = gridDim.x * gridDim.y * gridDim.z;
    unsigned sum, cnt, mine, sp = 0u;
    for (;;) {
        sum = 0u; cnt = 0u; mine = 0u;
#pragma unroll
        for (unsigned j = 0; j < 16; ++j) { const unsigned c = xb_ld(&bar[XB_XCNT(j)]); sum += c; cnt += (c > 0u) ? 1u : 0u; mine = (j == x) ? c : mine; }
        if (sum == G) break;
        __builtin_amdgcn_s_sleep(1);
        if ((++sp & 255u) == 0u) { if (xb_ld(&bar[XB_TMO])) break; if (sp > XB_SPIN_CAP) { atomicAdd(&bar[XB_TMO], 1u); break; } }
    }
    nloc = mine > 0u ? mine : 1u; nx = cnt > 0u ? cnt : 1u;
}
__device__ __forceinline__ void xcd_barrier(const XcdBarrier& b) {
    asm volatile("s_waitcnt vmcnt(0)" ::: "memory");
    __syncthreads();
    if (threadIdx.x == 0) {
        unsigned* bar = b.bar;
        __builtin_amdgcn_s_waitcnt(0);
        unsigned nloc = b.st[0], nx = b.st[1];
        if (nloc == 0u) { xcd_barrier_complete(bar, b.x, nloc, nx); b.st[0] = nloc; b.st[1] = nx; }
        const unsigned old = xb_add(&bar[XB_XSUB(b.x)], 1u);
        const unsigned gen = old / nloc;
        if (old + 1u == (gen + 1u) * nloc) {
            __builtin_amdgcn_fence(__ATOMIC_RELEASE, "agent");
            asm volatile("s_waitcnt vmcnt(0)" ::: "memory");
            const unsigned og = xb_add(&bar[XB_TOP], 1u);
            const unsigned tg = og / nx;
            if (og + 1u == (tg + 1u) * nx) xb_add(&bar[XB_TOPGEN], 1u);
            else XB_SPIN(xb_ld(&bar[XB_TOPGEN]) == tg, bar);
            __builtin_amdgcn_fence(__ATOMIC_ACQUIRE, "agent");
            xb_add(&bar[XB_XGEN(b.x)], 1u);
            asm volatile("s_waitcnt vmcnt(0)" ::: "memory");
        } else {
            XB_SPIN(xb_ld(&bar[XB_XGEN(b.x)]) == gen, bar);
            __builtin_amdgcn_fence(__ATOMIC_ACQUIRE, "agent");
            asm volatile("s_waitcnt vmcnt(0)" ::: "memory");
        }
    }
    __syncthreads();
}

struct Args {
    const float *x_prompt, *x_sample, *cache_k, *cache_v, *state_conv, *rel_bias, *w_in, *w_conv, *w_conv_out, *sinks, *w_attn_out, *w_o, *g_mix, *g_ffn, *w_gate, *w_up, *w_down, *g_final;
    float* out; unsigned char* ws; int ph_lo, ph_hi;
};
struct Frame { LAS unsigned char* lds; int tid, lane, wave, vcu, G; };

static __device__ const unsigned char T5_BUCKET[128] = {
    0, 1, 2, 3, 4, 5, 6, 7, 8, 9, 10, 11, 12, 13, 14, 15, 16, 16, 16, 17, 17, 18, 18, 18, 19, 19, 19, 20, 20, 20, 20, 21, 21, 21, 21, 22, 22, 22, 22, 22, 23, 23, 23, 23, 23, 23,
    24, 24, 24, 24, 24, 24, 25, 25, 25, 25, 25, 25, 25, 26, 26, 26, 26, 26, 26, 26, 26, 27, 27, 27, 27, 27, 27, 27, 27, 27, 27, 28, 28, 28, 28, 28, 28, 28, 28, 28, 28,
    29, 29, 29, 29, 29, 29, 29, 29, 29, 29, 29, 29, 30, 30, 30, 30, 30, 30, 30, 30, 30, 30, 30, 30, 30, 30, 31, 31, 31, 31, 31, 31, 31, 31, 31, 31, 31, 31, 31, 31, 31};

constexpr int P0_PITCH = 520;
struct P0Item { const float* W; bf16_t* WT; const float* gk; int K, N, k0, n0, dr; };
__device__ __forceinline__ bool p0_decode(const Args& a, unsigned char* ws, int it, P0Item& q) {
    constexpr int T_IN = (D / 128) * (NIN / 128), T_C = (DC / 128) * (D / 128), T_A = T_C, T_O = (D / 128) * (D / 128), T_G = (D / 128) * (FF / 128), T_U = T_G, T_D = (FF / 128) * (D / 128);
    int r = it; q.gk = nullptr;
    if (r < T_IN) { const int nb = NIN / 128; q.W = a.w_in; q.WT = (bf16_t*)(ws + WS_WIN); q.K = D; q.N = NIN; q.k0 = 128 * (r / nb); q.n0 = 128 * (r % nb);
        const int n0 = q.n0; q.dr = n0 < 1024 ? n0 : n0 < 2048 ? 1024 + 2 * (n0 - 1024) : n0 < 3072 ? 1024 + 2 * (n0 - 2048) + 128 : n0; return true; } r -= T_IN;
    if (r < T_C) { const int nb = D / 128; q.W = a.w_conv_out; q.WT = (bf16_t*)(ws + WS_WC); q.K = DC; q.N = D; q.k0 = 128 * (r / nb); q.n0 = 128 * (r % nb); q.dr = q.n0; return true; } r -= T_C;
    if (r < T_A) { const int nb = D / 128; q.W = a.w_attn_out; q.WT = (bf16_t*)(ws + WS_WA); q.K = DA; q.N = D; q.k0 = 128 * (r / nb); q.n0 = 128 * (r % nb); q.dr = q.n0; return true; } r -= T_A;
    if (r < T_O) { const int nb = D / 128; q.W = a.w_o; q.WT = (bf16_t*)(ws + WS_WO); q.K = D; q.N = D; q.k0 = 128 * (r / nb); q.n0 = 128 * (r % nb); q.dr = q.n0; return true; } r -= T_O;
    if (r < T_G) { const int nb = FF / 128; q.W = a.w_gate; q.WT = (bf16_t*)(ws + WS_WGU); q.gk = a.g_ffn; q.K = D; q.N = FF; q.k0 = 128 * (r / nb); q.n0 = 128 * (r % nb); q.dr = 2 * q.n0; return true; } r -= T_G;
    if (r < T_U) { const int nb = FF / 128; q.W = a.w_up; q.WT = (bf16_t*)(ws + WS_WGU); q.gk = a.g_ffn; q.K = D; q.N = FF; q.k0 = 128 * (r / nb); q.n0 = 128 * (r % nb); q.dr = 2 * q.n0 + 128; return true; } r -= T_U;
    if (r < T_D) { const int nb = D / 128; q.W = a.w_down; q.WT = (bf16_t*)(ws + WS_WD); q.K = FF; q.N = D; q.k0 = 128 * (r / nb); q.n0 = 128 * (r % nb); q.dr = q.n0; return true; }
    return false;
}
__device__ __forceinline__ void p0_load(const P0Item& q, int tid, f32x4 (&v)[8]) {
    const int c4 = tid & 31, kr = tid >> 5;
#pragma unroll
    for (int i = 0; i < 4; ++i) { const int k = q.k0 + 2 * (kr + 16 * i); const float* p = q.W + (size_t)k * q.N + q.n0 + 4 * c4;
        v[2 * i] = *(const f32x4*)p; v[2 * i + 1] = *(const f32x4*)(p + q.N);
        if (q.gk) { const float g0 = q.gk[k], g1 = q.gk[k + 1]; v[2 * i] = v[2 * i] * g0; v[2 * i + 1] = v[2 * i + 1] * g1; } }
}
__device__ __forceinline__ void p0_prologue(const Frame& F, const Args& a) {
    unsigned char* ws = a.ws;
    LAS unsigned char* T2 = F.lds;
    const int tid = F.tid;
    constexpr int NITEMS = (D / 128) * (NIN / 128) + 2 * (DC / 128) * (D / 128) + (D / 128) * (D / 128) + 2 * (D / 128) * (FF / 128) + (FF / 128) * (D / 128);
    { float* rs = (float*)((unsigned*)(ws + WS_CTL) + CW_ROWSS); for (int i = F.vcu * (NWAVES * 64) + tid; i < M; i += F.G * (NWAVES * 64)) rs[i] = 0.f;
      if (blockIdx.x == 0 && tid < 3 * 36) ((unsigned*)(ws + WS_CTL))[CW_CNT + tid * 64] = 0u; }
    P0Item q, qn; f32x4 v[8];
    int it = F.vcu; bool have = p0_decode(a, ws, it, q);
    if (have) p0_load(q, tid, v);
    while (have) {
        { const int c4 = tid & 31, kr = tid >> 5;
#pragma unroll
          for (int i = 0; i < 4; ++i) { u32x4 w; w.x = cvt_pk_bf16(v[2 * i][0], v[2 * i + 1][0]); w.y = cvt_pk_bf16(v[2 * i][1], v[2 * i + 1][1]); w.z = cvt_pk_bf16(v[2 * i][2], v[2 * i + 1][2]); w.w = cvt_pk_bf16(v[2 * i][3], v[2 * i + 1][3]);
              LAS unsigned char* tp = T2 + (kr + 16 * i) * P0_PITCH + c4 * 16; *(LAS u32x2*)tp = (u32x2){w.x, w.y}; *(LAS u32x2*)(tp + 8) = (u32x2){w.z, w.w}; } }
        __syncthreads();
        it += F.G; const bool hn = p0_decode(a, ws, it, qn);
        if (hn) p0_load(qn, tid, v);
        { const int k8 = tid & 15, nr = tid >> 4;
#pragma unroll
          for (int i = 0; i < 4; ++i) { const int n = nr + 32 * i; LAS const unsigned char* p = T2 + (4 * k8) * P0_PITCH + n * 4;
              u32x4 o; o.x = *(LAS const unsigned*)(p); o.y = *(LAS const unsigned*)(p + P0_PITCH); o.z = *(LAS const unsigned*)(p + 2 * P0_PITCH); o.w = *(LAS const unsigned*)(p + 3 * P0_PITCH);
              *(u32x4*)(q.WT + (size_t)(q.dr + n) * q.K + q.k0 + 8 * k8) = o; } }
        __syncthreads();
        q = qn; have = hn;
    }
    const int gw = F.vcu * NWAVES + F.wave, NGW = F.G * NWAVES;
    bf16_t* XN = (bf16_t*)(ws + WS_XN);
    for (int m = gw; m < M; m += NGW) {
        const float* xrow = (m < MP) ? a.x_prompt + (size_t)m * D : a.x_sample + (size_t)(m - MP) * D;
        const f32x4* xr = (const f32x4*)xrow + F.lane; const f32x4* gr = (const f32x4*)a.g_mix + F.lane;
        f32x4 xv[8]; float s = 0.f;
#pragma unroll
        for (int j = 0; j < 8; ++j) { xv[j] = xr[64 * j]; s += (xv[j][0] * xv[j][0] + xv[j][1] * xv[j][1]) + (xv[j][2] * xv[j][2] + xv[j][3] * xv[j][3]); }
        const float rstd = __builtin_amdgcn_rsqf(wave_sum(s) * (1.0f / D) + EPS);
        u32x2* o8 = (u32x2*)(XN + (size_t)m * D) + F.lane;
#pragma unroll
        for (int j = 0; j < 8; ++j) { const f32x4 g = gr[64 * j]; u32x2 w; w.x = cvt_pk_bf16(xv[j][0] * rstd * g[0], xv[j][1] * rstd * g[1]); w.y = cvt_pk_bf16(xv[j][2] * rstd * g[2], xv[j][3] * rstd * g[3]); o8[64 * j] = w; }
    }
}

constexpr int KIMG_STRIDE = 144, VT_STRIDE = 528;
constexpr int LDS_KIMG = 0, LDS_VT = 256 * KIMG_STRIDE, LDS_LUT = LDS_VT + 64 * VT_STRIDE, LDS_SINK = LDS_LUT + 4 * 128 * 4;
static_assert(LDS_SINK + 16 <= RING_BYTES, "attention LDS");

__device__ __forceinline__ void attn_group(LAS const unsigned char* lds, const int key0, const bf16x8 q0, const bf16x8 q1, const int dist0, const int min_krow, const int hl, bf16_t* outp, const int lane) {
    const int l15 = lane & 15, g = lane >> 4;
    f32x4 s[10];
    LAS const unsigned char* kp = lds + LDS_KIMG + (key0 + l15) * KIMG_STRIDE + g * 16;
#pragma unroll
    for (int T = 0; T < 10; ++T) {
        const bf16x8 k0f = *(LAS const bf16x8*)(kp + T * 16 * KIMG_STRIDE), k1f = *(LAS const bf16x8*)(kp + T * 16 * KIMG_STRIDE + 64);
        f32x4 a = (f32x4){0.f, 0.f, 0.f, 0.f};
        a = __builtin_amdgcn_mfma_f32_16x16x32_bf16(k0f, q0, a, 0, 0, 0);
        a = __builtin_amdgcn_mfma_f32_16x16x32_bf16(k1f, q1, a, 0, 0, 0);
        s[T] = a;
    }
    LAS const float* lut = (LAS const float*)(lds + LDS_LUT) + hl * 128;
    float mx = -INFINITY;
#pragma unroll
    for (int T = 0; T < 10; ++T)
#pragma unroll
        for (int r = 0; r < 4; ++r) {
            const int kk = 16 * T + 4 * g + r, dist = dist0 - kk;
            const bool valid = ((unsigned)dist < 128u) && (key0 + kk >= min_krow);
            const float v = valid ? s[T][r] + lut[dist & 127] : -INFINITY;
            s[T][r] = v; mx = fmaxf(mx, v);
        }
    mx = fmaxf(mx, __shfl_xor(mx, 16)); mx = fmaxf(mx, __shfl_xor(mx, 32));
    const float sink = ((LAS const float*)(lds + LDS_SINK))[hl];
    mx = fmaxf(mx, sink);
    float sum = 0.f;
#pragma unroll
    for (int T = 0; T < 10; ++T)
#pragma unroll
        for (int r = 0; r < 4; ++r) { const float p = __expf(s[T][r] - mx); s[T][r] = p; sum += p; }
    sum += __shfl_xor(sum, 16); sum += __shfl_xor(sum, 32);
    sum += __expf(sink - mx);
    const float inv = 1.0f / sum;
    bf16x8 pf[5];
#pragma unroll
    for (int P = 0; P < 5; ++P) pf[P] = __builtin_bit_cast(bf16x8, pg8::pack8(s[2 * P] * inv, s[2 * P + 1] * inv));
#pragma unroll
    for (int dt = 0; dt < 4; ++dt) {
        f32x4 o = (f32x4){0.f, 0.f, 0.f, 0.f};
        LAS const unsigned char* vp = lds + LDS_VT + (16 * dt + l15) * VT_STRIDE + (key0 + 4 * g) * 2;
#pragma unroll
        for (int P = 0; P < 5; ++P) {
            const u32x2 lo = *(LAS const u32x2*)(vp + 64 * P), hi = *(LAS const u32x2*)(vp + 64 * P + 32);
            const bf16x8 vf = __builtin_bit_cast(bf16x8, (u32x4){lo.x, lo.y, hi.x, hi.y});
            o = __builtin_amdgcn_mfma_f32_16x16x32_bf16(vf, pf[P], o, 0, 0, 0);
        }
        u32x2 w; w.x = cvt_pk_bf16(o[0], o[1]); w.y = cvt_pk_bf16(o[2], o[3]);
        *(u32x2*)(outp + 16 * dt + 4 * g) = w;
    }
}

__device__ __forceinline__ void p2_attention_conv(const Frame& F, const Args& a) {
    unsigned char* ws = a.ws;
    const bf16_t* Qb = (const bf16_t*)(ws + WS_Q); const bf16_t* Kb = (const bf16_t*)(ws + WS_K); const bf16_t* Vb = (const bf16_t*)(ws + WS_V);
    bf16_t* ATT = (bf16_t*)(ws + WS_ATT);
    LAS unsigned char* lds = F.lds;
    const int tid = F.tid, lane = F.lane, wave = F.wave, l15 = lane & 15, g = lane >> 4;
    for (int u = blockIdx.x; u < NBATCH * 16 * 4; u += F.G) {
        const int b = u >> 6, nb = (u >> 2) & 15, kvh = u & 3;
        __syncthreads();
        {
            const int hl = tid >> 7, dist = tid & 127;
            ((LAS float*)(lds + LDS_LUT))[tid] = a.rel_bias[T5_BUCKET[dist] * 16 + kvh * 4 + hl];
            if (tid < 4) ((LAS float*)(lds + LDS_SINK))[tid] = a.sinks[kvh * 4 + tid];
        }
#pragma unroll
        for (int i = 0; i < 4; ++i) {
            const int id = tid + 512 * i, r = id >> 3, c8 = id & 7, t = nb * WIN - WIN + r;
            u32x4 kv = (u32x4){0u, 0u, 0u, 0u}, vv = (u32x4){0u, 0u, 0u, 0u};
            if (t >= 0) { const size_t off = (size_t)(b * SEQ + t) * DKV + kvh * 64 + c8 * 8; kv = *(const u32x4*)(Kb + off); vv = *(const u32x4*)(Vb + off); }
            *(LAS u32x4*)(lds + LDS_KIMG + r * KIMG_STRIDE + c8 * 16) = kv;
            LAS unsigned char* vt = lds + LDS_VT + (c8 * 8) * VT_STRIDE + r * 2;
            *(LAS bf16_t*)(vt + 0 * VT_STRIDE) = (bf16_t)(vv.x & 0xffffu); *(LAS bf16_t*)(vt + 1 * VT_STRIDE) = (bf16_t)(vv.x >> 16);
            *(LAS bf16_t*)(vt + 2 * VT_STRIDE) = (bf16_t)(vv.y & 0xffffu); *(LAS bf16_t*)(vt + 3 * VT_STRIDE) = (bf16_t)(vv.y >> 16);
            *(LAS bf16_t*)(vt + 4 * VT_STRIDE) = (bf16_t)(vv.z & 0xffffu); *(LAS bf16_t*)(vt + 5 * VT_STRIDE) = (bf16_t)(vv.z >> 16);
            *(LAS bf16_t*)(vt + 6 * VT_STRIDE) = (bf16_t)(vv.w & 0xffffu); *(LAS bf16_t*)(vt + 7 * VT_STRIDE) = (bf16_t)(vv.w >> 16);
        }
        __syncthreads();
        const int hl = wave >> 1, head = kvh * 4 + hl;
#pragma unroll 1
        for (int i = 0; i < 4; ++i) {
            const int qg = (wave & 1) * 4 + i, qi0 = 16 * qg, key0 = 16 * (qg & ~1);
            const size_t row = (size_t)b * SEQ + nb * WIN + qi0 + l15;
            const bf16_t* qp = Qb + row * DA + head * 64 + 8 * g;
            const bf16x8 q0 = *(const bf16x8*)qp, q1 = *(const bf16x8*)(qp + 32);
            attn_group(lds, key0, q0, q1, qi0 + l15 + WIN - key0, nb == 0 ? WIN : 0, hl, ATT + row * DA + head * 64, lane);
        }
    }
    for (int u = blockIdx.x; u < DBATCH * 4; u += F.G) {
        const int b = u >> 2, kvh = u & 3;
        __syncthreads();
        {
            const int hl = tid >> 7, dist = tid & 127;
            ((LAS float*)(lds + LDS_LUT))[tid] = a.rel_bias[T5_BUCKET[dist] * 16 + kvh * 4 + hl];
            if (tid < 4) ((LAS float*)(lds + LDS_SINK))[tid] = a.sinks[kvh * 4 + tid];
        }
#pragma unroll
        for (int i = 0; i < 4; ++i) {
            const int id = tid + 512 * i, j = id >> 4, c4 = id & 15;
            const size_t off = ((size_t)(b * WIN + j) * 4 + kvh) * 64 + c4 * 4;
            const f32x4 kf = *(const f32x4*)(a.cache_k + off), vf = *(const f32x4*)(a.cache_v + off);
            if (j >= DSEQ) { const size_t oo = ((size_t)(b * WIN + j - DSEQ) * 4 + kvh) * 64 + c4 * 4; *(f32x4*)(a.out + OUT_KS + oo) = kf; *(f32x4*)(a.out + OUT_VS + oo) = vf; }
            u32x2 kw; kw.x = cvt_pk_bf16(kf[0], kf[1]); kw.y = cvt_pk_bf16(kf[2], kf[3]);
            *(LAS u32x2*)(lds + LDS_KIMG + j * KIMG_STRIDE + c4 * 8) = kw;
            const unsigned v01 = cvt_pk_bf16(vf[0], vf[1]), v23 = cvt_pk_bf16(vf[2], vf[3]);
            LAS unsigned char* vt = lds + LDS_VT + (c4 * 4) * VT_STRIDE + j * 2;
            *(LAS bf16_t*)(vt + 0 * VT_STRIDE) = (bf16_t)(v01 & 0xffffu); *(LAS bf16_t*)(vt + 1 * VT_STRIDE) = (bf16_t)(v01 >> 16);
            *(LAS bf16_t*)(vt + 2 * VT_STRIDE) = (bf16_t)(v23 & 0xffffu); *(LAS bf16_t*)(vt + 3 * VT_STRIDE) = (bf16_t)(v23 >> 16);
        }
        if (tid < 256) {
            const int r = WIN + (tid >> 3), c8 = tid & 7;
            u32x4 kv = (u32x4){0u, 0u, 0u, 0u}, vv = (u32x4){0u, 0u, 0u, 0u};
            if (r < WIN + DSEQ) { const size_t off = (size_t)(MP + b * DSEQ + (r - WIN)) * DKV + kvh * 64 + c8 * 8; kv = *(const u32x4*)(Kb + off); vv = *(const u32x4*)(Vb + off); }
            *(LAS u32x4*)(lds + LDS_KIMG + r * KIMG_STRIDE + c8 * 16) = kv;
            LAS unsigned char* vt = lds + LDS_VT + (c8 * 8) * VT_STRIDE + r * 2;
            *(LAS bf16_t*)(vt + 0 * VT_STRIDE) = (bf16_t)(vv.x & 0xffffu); *(LAS bf16_t*)(vt + 1 * VT_STRIDE) = (bf16_t)(vv.x >> 16);
            *(LAS bf16_t*)(vt + 2 * VT_STRIDE) = (bf16_t)(vv.y & 0xffffu); *(LAS bf16_t*)(vt + 3 * VT_STRIDE) = (bf16_t)(vv.y >> 16);
            *(LAS bf16_t*)(vt + 4 * VT_STRIDE) = (bf16_t)(vv.z & 0xffffu); *(LAS bf16_t*)(vt + 5 * VT_STRIDE) = (bf16_t)(vv.z >> 16);
            *(LAS bf16_t*)(vt + 6 * VT_STRIDE) = (bf16_t)(vv.w & 0xffffu); *(LAS bf16_t*)(vt + 7 * VT_STRIDE) = (bf16_t)(vv.w >> 16);
        }
        __syncthreads();
        if (wave < 2) {
            const int t = l15 & 7, hl = 2 * wave + (l15 >> 3), head = kvh * 4 + hl;
            const size_t row = (size_t)MP + b * DSEQ + t;
            const bf16_t* qp = Qb + row * DA + head * 64 + 8 * g;
            const bf16x8 q0 = *(const bf16x8*)qp, q1 = *(const bf16x8*)(qp + 32);
            attn_group(lds, 0, q0, q1, t + WIN, 0, hl, ATT + row * DA + head * 64, lane);
        }
    }
    __syncthreads();
    {
        const bf16_t* U = (const bf16_t*)(ws + WS_U); const bf16_t* Bg = (const bf16_t*)(ws + WS_BG); bf16_t* AC = (bf16_t*)(ws + WS_ACONV);
        for (int id = blockIdx.x * (NWAVES * 64) + tid; id < M * (DC / 8); id += F.G * (NWAVES * 64)) {
            const int row = id >> 7, c = (id & 127) * 8;
            f32x4 u2a, u2b, u1a, u1b, u0a, u0b, ba, bb;
            pg8::unpack8(*(const u32x4*)(U + (size_t)row * DC + c), u0a, u0b);
            pg8::unpack8(*(const u32x4*)(Bg + (size_t)row * DC + c), ba, bb);
            int t; const float* st = nullptr;
            if (row < MP) t = row & (SEQ - 1); else { const int s = row - MP; t = s & 7; st = a.state_conv + (size_t)(s >> 3) * 2 * DC + c; }
            if (t >= 1) pg8::unpack8(*(const u32x4*)(U + (size_t)(row - 1) * DC + c), u1a, u1b);
            else if (st) { u1a = *(const f32x4*)(st + DC); u1b = *(const f32x4*)(st + DC + 4); }
            else { u1a = (f32x4){0.f, 0.f, 0.f, 0.f}; u1b = u1a; }
            if (t >= 2) pg8::unpack8(*(const u32x4*)(U + (size_t)(row - 2) * DC + c), u2a, u2b);
            else if (st) { const float* p = st + (t == 1 ? DC : 0); u2a = *(const f32x4*)p; u2b = *(const f32x4*)(p + 4); }
            else { u2a = (f32x4){0.f, 0.f, 0.f, 0.f}; u2b = u2a; }
            const f32x4 w0a = *(const f32x4*)(a.w_conv + c), w0b = *(const f32x4*)(a.w_conv + c + 4), w1a = *(const f32x4*)(a.w_conv + DC + c), w1b = *(const f32x4*)(a.w_conv + DC + c + 4),
                        w2a = *(const f32x4*)(a.w_conv + 2 * DC + c), w2b = *(const f32x4*)(a.w_conv + 2 * DC + c + 4);
            const f32x4 oa = ba * (w0a * u2a + w1a * u1a + w2a * u0a), ob = bb * (w0b * u2b + w1b * u1b + w2b * u0b);
            *(u32x4*)(AC + (size_t)row * DC + c) = pg8::pack8(oa, ob);
        }
    }
}

__device__ __forceinline__ void p7_final_norm(const Frame& F, const Args& a) {
    const int gw = F.vcu * NWAVES + F.wave, NGW = F.G * NWAVES;
    for (int m = gw; m < M; m += NGW) {
        f32x4* xr = (f32x4*)(a.out + OUT_Y + (size_t)m * D) + F.lane; const f32x4* gr = (const f32x4*)a.g_final + F.lane;
        f32x4 v[8]; float s = 0.f;
        const u32x2* pr = (const u32x2*)((const bf16_t*)(a.ws + WS_SG1) + (size_t)m * D) + F.lane;
#pragma unroll
        for (int j = 0; j < 8; ++j) { const u32x2 pw = pr[64 * j]; v[j] = xr[64 * j] + (f32x4){bf_lo(pw.x), bf_hi(pw.x), bf_lo(pw.y), bf_hi(pw.y)}; s += (v[j][0] * v[j][0] + v[j][1] * v[j][1]) + (v[j][2] * v[j][2] + v[j][3] * v[j][3]); }
        const float rstd = __builtin_amdgcn_rsqf(wave_sum(s) * (1.0f / D) + EPS);
#pragma unroll
        for (int j = 0; j < 8; ++j) xr[64 * j] = v[j] * rstd * gr[64 * j];
    }
}

constexpr int N_PHASES = 5;
__global__ void __launch_bounds__(NWAVES * 64, 2) fwd_kernel(Args args) {
    extern __shared__ __attribute__((aligned(16))) unsigned char lds_raw[];
    Frame F;
    F.lds = (LAS unsigned char*)lds_raw;
    F.tid = threadIdx.x; F.lane = F.tid & 63; F.wave = __builtin_amdgcn_readfirstlane(F.tid >> 6);
    F.G = gridDim.x; { const int bx = blockIdx.x; F.vcu = (F.G % 8 == 0) ? (bx % 8) * (F.G / 8) + bx / 8 : bx; }
    unsigned char* ws = args.ws;
    unsigned* ctl = (unsigned*)(ws + WS_CTL);
    volatile LAS unsigned* MISC = (volatile LAS unsigned*)(F.lds + MISC_OFF);
    for (int u = F.tid; u < (LDS_BYTES - LDSCTL_OFF) / 4; u += NWAVES * 64) ((LAS unsigned*)(F.lds + LDSCTL_OFF))[u] = 0u;
    __syncthreads();
    XcdBarrier bar; bar.bar = ctl + CW_BAR; bar.x = 0; bar.st = nullptr;
    if (MK_N_LAUNCHES == 1) bar = xcd_barrier_post(ctl + CW_BAR, MISC + 8);
    const int lo = args.ph_lo, hi = args.ph_hi;
#define IN(k) (lo <= (k) && (k) < hi)
#define SEAM(k) do { if (IN(k) && IN((k) + 1)) xcd_barrier(bar); } while (0)
    float* rowss = (float*)(ctl + CW_ROWSS);

#ifndef REP0
#define REP0 1
#endif
#ifndef REP2
#define REP2 1
#endif
    if (IN(0)) { for (int rep = 0; rep < REP0; ++rep) { p0_prologue(F, args); SEAM(0); } }
    if (IN(1)) {
        pg8::SchedG S; S.o.init(M / 256, NIN / 256, F.G, (int)blockIdx.x); S.A = (const char*)(ws + WS_XN); S.B = (const char*)(ws + WS_WIN); S.tstep = (size_t)256 * D * 2;
        pg8::EpiIn E{(bf16_t*)(ws + WS_BG), (bf16_t*)(ws + WS_U), (bf16_t*)(ws + WS_Q), (bf16_t*)(ws + WS_K), (bf16_t*)(ws + WS_V), (bf16_t*)(ws + WS_SG1), (bf16_t*)(ws + WS_SG2), args.out};
        pg8::gemm_phase(F.lds, D, S, E);
        SEAM(1);
    }
    if (IN(2)) { for (int rep = 0; rep < REP2; ++rep) { p2_attention_conv(F, args); SEAM(2); } }
    if (IN(3)) {
        pg8::StreamSched S; S.x = F.vcu >> 5; S.r = F.vcu & 31;
        S.c.ACONV = (const char*)(ws + WS_ACONV); S.c.ATT = (const char*)(ws + WS_ATT); S.c.WC = (const char*)(ws + WS_WC); S.c.WA = (const char*)(ws + WS_WA);
        S.c.MERGED = (const char*)(ws + WS_SG1); S.c.WO = (const char*)(ws + WS_WO); S.c.HB = (const char*)(ws + WS_SG2); S.c.WGU = (const char*)(ws + WS_WGU);
        S.c.ACT1 = (const char*)(ws + WS_ACT1); S.c.ACT2 = (const char*)(ws + WS_ACT2); S.c.WD = (const char*)(ws + WS_WD); S.c.cnt = ctl + CW_CNT;
        pg8::EpiStream E{(bf16_t*)(ws + WS_SG1), (bf16_t*)(ws + WS_SG2), args.x_prompt, args.x_sample, args.out + OUT_Y, rowss, (bf16_t*)(ws + WS_ACT1), (bf16_t*)(ws + WS_ACT2)};
        pg8::gemm_stream(F.lds, MISC + 16, S, E, ctl + CW_TMO);
        SEAM(3);
    }
    if (IN(4)) { p7_final_norm(F, args); }
#undef IN
#undef SEAM
}

extern "C" void kernel_launch(void* const* d_in, const int* in_sizes, int n_in, void* d_out, int out_size, void* d_ws, size_t ws_size, hipStream_t stream) {
    static int grid = 0;
    if (grid == 0) {
        if (n_in != 18 || (size_t)out_size != OUT_END || ws_size < WS_END) { fprintf(stderr, "kernel_launch: unexpected shapes: n_in %d out %d ws %zu (need %zu)\n", n_in, out_size, ws_size, (size_t)WS_END); grid = -1; return; }
        int dev = 0, cus = 0, per_cu = 0;
        if (hipGetDevice(&dev) != hipSuccess || hipDeviceGetAttribute(&cus, hipDeviceAttributeMultiprocessorCount, dev) != hipSuccess) { grid = -1; return; }
        if (hipFuncSetAttribute((const void*)fwd_kernel, hipFuncAttributeMaxDynamicSharedMemorySize, LDS_BYTES) != hipSuccess) { fprintf(stderr, "kernel_launch: hipFuncSetAttribute failed\n"); grid = -1; return; }
        if (hipOccupancyMaxActiveBlocksPerMultiprocessor(&per_cu, (const void*)fwd_kernel, NWAVES * 64, LDS_BYTES) != hipSuccess || per_cu < 1) { fprintf(stderr, "kernel_launch: occupancy query says %d blocks per CU\n", per_cu); per_cu = 1; }
        (void)hipGetLastError();
        grid = cus;
    }
    if (grid < 0) return;
    (void)hipMemsetAsync((char*)d_ws + WS_CTL, 0, CTL_ZERO_BYTES, stream);
    Args a{};
    a.x_prompt = (const float*)d_in[0]; a.x_sample = (const float*)d_in[1]; a.cache_k = (const float*)d_in[2]; a.cache_v = (const float*)d_in[3]; a.state_conv = (const float*)d_in[4];
    a.rel_bias = (const float*)d_in[5]; a.w_in = (const float*)d_in[6]; a.w_conv = (const float*)d_in[7]; a.w_conv_out = (const float*)d_in[8]; a.sinks = (const float*)d_in[9];
    a.w_attn_out = (const float*)d_in[10]; a.w_o = (const float*)d_in[11]; a.g_mix = (const float*)d_in[12]; a.g_ffn = (const float*)d_in[13]; a.w_gate = (const float*)d_in[14];
    a.w_up = (const float*)d_in[15]; a.w_down = (const float*)d_in[16]; a.g_final = (const float*)d_in[17];
    a.out = (float*)d_out; a.ws = (unsigned char*)d_ws;
    if (MK_N_LAUNCHES == 1) {
        a.ph_lo = 0; a.ph_hi = N_PHASES;
        void* kargs[] = {&a};
        hipError_t e = hipLaunchCooperativeKernel((const void*)fwd_kernel, dim3(grid), dim3(NWAVES * 64), kargs, LDS_BYTES, stream);
        if (e != hipSuccess) fprintf(stderr, "kernel_launch: cooperative launch failed: %s (grid %d)\n", hipGetErrorString(e), grid);
    } else {
        for (int p = 0; p < N_PHASES; ++p) {
            a.ph_lo = p; a.ph_hi = p + 1;
            hipLaunchKernelGGL(fwd_kernel, dim3(grid), dim3(NWAVES * 64), LDS_BYTES, stream, a);
        }
    }
}
```

```cpp
#include <hip/hip_runtime.h>
#include <cstdio>
#include <cstdint>

#ifndef MK_N_LAUNCHES
#define MK_N_LAUNCHES 1
#endif

#define LAS __attribute__((address_space(3)))
#define GAS __attribute__((address_space(1)))
typedef unsigned short bf16_t;
typedef short bf16x8 __attribute__((ext_vector_type(8)));
typedef float f32x4 __attribute__((ext_vector_type(4)));
typedef unsigned u32x4 __attribute__((ext_vector_type(4)));
typedef unsigned u32x2 __attribute__((ext_vector_type(2)));

constexpr int D = 2048, DC = 1024, DA = 1024, DKV = 256, NIN = 8704, FF = 5632, NGU = 2 * FF;
constexpr int MP = 8192, MS = 1024, M = MP + MS;
constexpr int SEQ = 2048, NBATCH = 4, DBATCH = 128, DSEQ = 8, WIN = 128;
constexpr float EPS = 1e-6f;
constexpr size_t OUT_Y = 0, OUT_KP = (size_t)M * D, OUT_VP = OUT_KP + 131072, OUT_CP = OUT_VP + 131072, OUT_KS = OUT_CP + 8192,
                 OUT_VS = OUT_KS + 4194304, OUT_CS = OUT_VS + 4194304, OUT_END = OUT_CS + 262144;
constexpr size_t MiB = 1u << 20;
constexpr size_t WS_CTL = 0, CTL_ZERO_BYTES = 1 * MiB;
constexpr size_t WS_WIN = 1 * MiB, WS_WC = 35 * MiB, WS_WA = 39 * MiB, WS_WO = 43 * MiB, WS_WGU = 51 * MiB, WS_WD = 95 * MiB;
constexpr size_t WS_XN = 117 * MiB, WS_ACONV = WS_XN, WS_ATT = WS_XN + 18 * MiB;
constexpr size_t WS_BG = 153 * MiB, WS_U = 171 * MiB, WS_Q = 189 * MiB, WS_K = 207 * MiB, WS_V = WS_K + (size_t)M * DKV * 2;
constexpr size_t WS_SG1 = 216 * MiB, WS_SG2 = 252 * MiB;
constexpr size_t WS_ACT1 = WS_BG;
constexpr size_t WS_ACT2 = 288 * MiB;
constexpr size_t WS_END = 288 * MiB + (size_t)14 * 256 * FF * 2;
static_assert(WS_V + (size_t)M * DKV * 2 == 216 * MiB && WS_ACT1 + (size_t)22 * 256 * FF * 2 <= 216 * MiB, "ws map");
constexpr int CW_BAR = 4096;
constexpr int CW_ROWSS = 32768;
constexpr int CW_CNT = 16384;
constexpr int CW_TICKET = 12288;
constexpr int CW_TMO = 8;

constexpr int RING_BYTES = 131072;
constexpr int LDSCTL_OFF = RING_BYTES, MISC_OFF = LDSCTL_OFF + 320;
constexpr int LDS_BYTES = 147456;
constexpr int NWAVES = 8;

#define LDS_WAIT() asm volatile("s_waitcnt lgkmcnt(0)" ::: "memory")
#define VM_WAIT() asm volatile("s_waitcnt vmcnt(0)" ::: "memory")
typedef float f32x2_t __attribute__((ext_vector_type(2))); typedef __bf16 bf16x2_t __attribute__((ext_vector_type(2)));
__device__ __forceinline__ unsigned cvt_pk_bf16(float lo, float hi) { const f32x2_t v = {lo, hi}; const bf16x2_t b = __builtin_convertvector(v, bf16x2_t); return __builtin_bit_cast(unsigned, b); }
__device__ __forceinline__ float bf_lo(unsigned w) { return __builtin_bit_cast(float, w << 16); }
__device__ __forceinline__ float bf_hi(unsigned w) { return __builtin_bit_cast(float, w & 0xffff0000u); }
__device__ __forceinline__ float fsigmoid(float x) { return __builtin_amdgcn_rcpf(1.0f + __expf(-x)); }
__device__ __forceinline__ float wave_sum(float v) {
#pragma unroll
    for (int o = 1; o < 64; o <<= 1) v += __shfl_xor(v, o);
    return v;
}

namespace pg8 {
constexpr int BM = 256, BK = 64, HALF = 128, HTB = HALF * BK * 2, STAGE_BYTES = 8 * HTB, NXCD = 8, WGM = 8;
__host__ __device__ __forceinline__ int lds_byte(int r, int c) { const int st = (r >> 4) * 2 + (c >> 5), rr = r & 15, cc = c & 31, ob = rr * 64 + cc * 2; return st * 1024 + (ob ^ (((ob >> 9) & 1) << 5)); }
__host__ __device__ __forceinline__ void stage_rc(int b, int& R, int& C) { const int st = b / 1024, sb = b % 1024, swz = sb ^ (((sb >> 9) & 1) << 5); R = (st >> 1) * 16 + swz / 64; C = (st & 1) * 32 + (swz % 64) / 2; }
__host__ __device__ __forceinline__ int perm32(int rho) { const int n = rho >> 4, i = rho & 15; return 8 * (i >> 2) + 4 * n + (i & 3); }

struct Unit { int pm, pn, aux; };
struct OrderMap {
    int nM, nN, nwg, G, c;
    __device__ __forceinline__ void init(int nM_, int nN_, int G_, int c_) { nM = nM_; nN = nN_; nwg = nM * nN; G = G_; c = c_; }
    __device__ __forceinline__ bool tile(int i, int& pm, int& pn) const {
        const long L = (long)i * G + c; if (L >= nwg) return false;
        int wgid = (int)L; { const int q = nwg / NXCD, r = nwg % NXCD, xcd = wgid % NXCD, off = wgid / NXCD; wgid = (xcd < r ? xcd * (q + 1) : r * (q + 1) + (xcd - r) * q) + off; }
        const int nig = WGM * nN, gid = wgid / nig, fm = gid * WGM, gsz = (nM - fm) < WGM ? (nM - fm) : WGM;
        pm = fm + ((wgid % nig) % gsz); pn = (wgid % nig) / gsz; return true;
    }
};
struct SchedG {
    OrderMap o; const char* A; const char* B; size_t tstep;
    __device__ __forceinline__ bool next(int i, Unit& u) const { u.aux = 0; return o.tile(i, u.pm, u.pn); }
    __device__ __forceinline__ const char* a_ptr(const Unit& u) const { return A + (size_t)u.pm * tstep; }
    __device__ __forceinline__ const char* b_ptr(const Unit& u) const { return B + (size_t)u.pn * tstep; }
};
struct SchedMix {
    OrderMap o; const char *A0, *A1, *B0, *B1; size_t tstep;
    __device__ __forceinline__ bool next(int i, Unit& u) const { u.aux = i & 1; return o.tile(i >> 1, u.pm, u.pn); }
    __device__ __forceinline__ const char* a_ptr(const Unit& u) const { return (u.aux ? A1 : A0) + (size_t)u.pm * tstep; }
    __device__ __forceinline__ const char* b_ptr(const Unit& u) const { return (u.aux ? B1 : B0) + (size_t)u.pn * tstep; }
};

template <class Epi, class Sched>
__device__ __forceinline__ void gemm_phase(LAS unsigned char* lds, const int K, const Sched& S, const Epi& E) {
    const int tid = threadIdx.x, wid = __builtin_amdgcn_readfirstlane(tid >> 6), lane = tid & 63, wr = wid >> 2, wc = wid & 3, fr = lane & 15, fq = lane >> 4;
    const int nt = K / BK;
    unsigned voffA[2], voffB[2];
#pragma unroll
    for (int i = 0; i < 2; ++i) { int R, C; stage_rc(tid * 16 + i * 8192, R, C); const int Rb = (R & ~31) + perm32(R & 31);
        voffA[i] = (unsigned)(R * K + C) * 2u; voffB[i] = (unsigned)(Rb * K + C) * 2u; }
    const size_t kstep = (size_t)(BK * 2);
    const size_t hstep = (size_t)HALF * K * 2;
    const unsigned ldsw = (unsigned)wid * 1024u;
    const int aoff = lds_byte(wr * 64 + fr, fq * 8), boff = lds_byte(wc * 32 + fr, fq * 8);
#define PG8_SA(b, h) (((b) * 2 + (h)) * HTB)
#define PG8_SB(b, h) ((4 + (b) * 2 + (h)) * HTB)
#define PG8_STAGE(bufoff, gbase, voff) do { _Pragma("unroll") for (int _i = 0; _i < 2; ++_i) \
        __builtin_amdgcn_global_load_lds((const unsigned*)((const char*)(gbase) + (voff)[_i]), (LAS unsigned*)(lds + (bufoff) + ldsw + _i * 8192), 16, 0, 0); } while (0)
#define PG8_LDA(dst, b, h) do { _Pragma("unroll") for (int m = 0; m < 4; ++m) _Pragma("unroll") for (int k = 0; k < 2; ++k) dst[m][k] = *(const LAS bf16x8*)(lds + PG8_SA(b, h) + aoff + m * 2048 + k * 1024); } while (0)
#define PG8_LDB(dst, b, h) do { _Pragma("unroll") for (int n = 0; n < 2; ++n) _Pragma("unroll") for (int k = 0; k < 2; ++k) dst[n][k] = *(const LAS bf16x8*)(lds + PG8_SB(b, h) + boff + n * 2048 + k * 1024); } while (0)
#define PG8_MMA(ai, bj, At, Bt) do { __builtin_amdgcn_s_setprio(1); _Pragma("unroll") for (int m = 0; m < 4; ++m) _Pragma("unroll") for (int n = 0; n < 2; ++n) _Pragma("unroll") for (int k = 0; k < 2; ++k) \
        acc[ai][bj][m][n] = __builtin_amdgcn_mfma_f32_16x16x32_bf16(Bt[n][k], At[m][k], acc[ai][bj][m][n], 0, 0, 0); __builtin_amdgcn_s_setprio(0); } while (0)
#define PG8_WAIT_V(n) asm volatile("s_waitcnt vmcnt(" #n ")" ::: "memory")
#define PG8_WAIT_L(n) asm volatile("s_waitcnt lgkmcnt(" #n ")" ::: "memory")
#define PG8_BAR __builtin_amdgcn_s_barrier()
#define PG8_SCHED __builtin_amdgcn_sched_barrier(0)
    Unit cur, nxt; int ui = 0;
    if (!S.next(0, cur)) return;
    f32x4 acc[2][2][4][2];
#pragma unroll
    for (int a = 0; a < 2; ++a)
#pragma unroll
        for (int b = 0; b < 2; ++b)
#pragma unroll
            for (int m = 0; m < 4; ++m)
#pragma unroll
                for (int n = 0; n < 2; ++n) acc[a][b][m][n] = (f32x4){0.f, 0.f, 0.f, 0.f};
    bf16x8 At[4][2], B0[2][2], B1[2][2];
    const char* cA = S.a_ptr(cur); const char* cB = S.b_ptr(cur);
    PG8_STAGE(PG8_SB(0, 0), cB, voffB); PG8_STAGE(PG8_SB(0, 1), cB + hstep, voffB); PG8_STAGE(PG8_SA(0, 0), cA, voffA); PG8_STAGE(PG8_SA(0, 1), cA + hstep, voffA);
    if (wr == 1) PG8_BAR;
    PG8_WAIT_V(2); PG8_BAR;
    PG8_STAGE(PG8_SB(1, 0), cB + kstep, voffB); PG8_STAGE(PG8_SA(1, 0), cA + kstep, voffA); PG8_STAGE(PG8_SB(1, 1), cB + hstep + kstep, voffB);
    PG8_WAIT_V(6); PG8_BAR;
    for (;;) {
        const bool has_next = S.next(ui + 1, nxt);
        const char* nA = has_next ? S.a_ptr(nxt) : cA; const char* nB = has_next ? S.b_ptr(nxt) : cB;
        for (int t = 0; t < nt; t += 2) {
            const bool last = (t == nt - 2);
            const char* a1 = cA + (size_t)(t + 1) * kstep;
            const char* a2 = last ? nA : cA + (size_t)(t + 2) * kstep; const char* b2 = last ? nB : cB + (size_t)(t + 2) * kstep;
            const char* a3 = a2 + kstep; const char* b3 = b2 + kstep;
            PG8_LDB(B0, 0, 0); PG8_LDB(B1, 0, 1); PG8_SCHED; PG8_LDA(At, 0, 0); PG8_STAGE(PG8_SA(1, 1), a1 + hstep, voffA);
            PG8_WAIT_V(8); PG8_WAIT_L(0); PG8_BAR; PG8_MMA(0, 0, At, B0); PG8_MMA(0, 1, At, B1); PG8_BAR; PG8_SCHED;
            PG8_LDA(At, 0, 1); PG8_STAGE(PG8_SB(0, 0), b2, voffB); PG8_STAGE(PG8_SB(0, 1), b2 + hstep, voffB); PG8_STAGE(PG8_SA(0, 0), a2, voffA);
            PG8_WAIT_V(8); PG8_WAIT_L(0); PG8_BAR; PG8_MMA(1, 0, At, B0); PG8_MMA(1, 1, At, B1); PG8_BAR; PG8_SCHED;
            PG8_LDB(B0, 1, 0); PG8_LDB(B1, 1, 1); PG8_SCHED; PG8_LDA(At, 1, 0); PG8_STAGE(PG8_SA(0, 1), a2 + hstep, voffA);
            PG8_WAIT_V(8); PG8_WAIT_L(0); PG8_BAR; PG8_MMA(0, 0, At, B0); PG8_MMA(0, 1, At, B1); PG8_BAR; PG8_SCHED;
            PG8_LDA(At, 1, 1); PG8_STAGE(PG8_SB(1, 0), b3, voffB); PG8_STAGE(PG8_SB(1, 1), b3 + hstep, voffB); PG8_STAGE(PG8_SA(1, 0), a3, voffA);
            PG8_WAIT_V(8); PG8_WAIT_L(0); PG8_BAR; PG8_MMA(1, 0, At, B0); PG8_MMA(1, 1, At, B1); PG8_BAR; PG8_SCHED;
        }
        if (wr == 0) PG8_BAR;
        E(acc, cur, wr, wc, fr, fq);
        if (!has_next) break;
        if (!E.keep(cur)) {
#pragma unroll
            for (int a = 0; a < 2; ++a)
#pragma unroll
                for (int b = 0; b < 2; ++b)
#pragma unroll
                    for (int m = 0; m < 4; ++m)
#pragma unroll
                        for (int n = 0; n < 2; ++n) acc[a][b][m][n] = (f32x4){0.f, 0.f, 0.f, 0.f};
        }
        cur = nxt; cA = nA; cB = nB; ++ui;
        if (wr == 1) PG8_BAR;
    }
    PG8_WAIT_V(0);
    PG8_BAR;
#undef PG8_SA
#undef PG8_SB
#undef PG8_STAGE
#undef PG8_LDA
#undef PG8_LDB
#undef PG8_MMA
#undef PG8_WAIT_V
#undef PG8_WAIT_L
#undef PG8_BAR
#undef PG8_SCHED
}

__device__ __forceinline__ u32x4 pack8(const f32x4 v0, const f32x4 v1) { u32x4 w; w.x = cvt_pk_bf16(v0[0], v0[1]); w.y = cvt_pk_bf16(v0[2], v0[3]); w.z = cvt_pk_bf16(v1[0], v1[1]); w.w = cvt_pk_bf16(v1[2], v1[3]); return w; }
__device__ __forceinline__ void unpack8(const u32x4 w, f32x4& v0, f32x4& v1) { v0 = (f32x4){bf_lo(w.x), bf_hi(w.x), bf_lo(w.y), bf_hi(w.y)}; v1 = (f32x4){bf_lo(w.z), bf_hi(w.z), bf_lo(w.w), bf_hi(w.w)}; }

struct EpiIn {
    bf16_t *Bg, *U, *Q, *Kb, *Vb, *SG1, *SG2; float* out;
    __device__ __forceinline__ bool keep(const Unit&) const { return false; }
    __device__ __forceinline__ void operator()(f32x4 (&acc)[2][2][4][2], const Unit& u, int wr, int wc, int fr, int fq) const {
        const int pn = u.pn, row0 = u.pm * BM + wr * 64 + fr, cl = wc * 32 + 8 * fq;
        if (pn >= 4 && pn < 12) {
            const int ch = 128 * (pn - 4) + cl;
#pragma unroll
            for (int ai = 0; ai < 2; ++ai)
#pragma unroll
                for (int m = 0; m < 4; ++m) {
                    const int row = row0 + ai * HALF + m * 16;
                    const f32x4 u0 = acc[ai][0][m][0] * acc[ai][1][m][0], u1 = acc[ai][0][m][1] * acc[ai][1][m][1];
                    *(u32x4*)(U + (size_t)row * DC + ch) = pack8(u0, u1);
                    bool st; size_t idx;
                    if (row < MP) { const int t = row & (SEQ - 1); st = t >= SEQ - 2; idx = OUT_CP + (size_t)((row >> 11) * 2 + (t - (SEQ - 2))) * DC + ch; }
                    else { const int s = row - MP, t = s & 7; st = t >= 6; idx = OUT_CS + (size_t)((s >> 3) * 2 + (t - 6)) * DC + ch; }
                    if (st) { *(f32x4*)(out + idx) = u0; *(f32x4*)(out + idx + 4) = u1; }
                }
            return;
        }
        bf16_t* dst; int ld, col0; float sc = 1.f; bool sig = false; int side = 0;
        if (pn < 4) { dst = Bg; ld = DC; col0 = 256 * pn; }
        else if (pn < 16) { dst = Q; ld = DA; col0 = 256 * (pn - 12); sc = 0.125f; }
        else if (pn == 16) { dst = Kb; ld = DKV; col0 = 0; side = 1; }
        else if (pn == 17) { dst = Vb; ld = DKV; col0 = 0; side = 2; }
        else if (pn < 26) { dst = SG1; ld = D; col0 = 256 * (pn - 18); sig = true; }
        else { dst = SG2; ld = D; col0 = 256 * (pn - 26); sig = true; }
#pragma unroll
        for (int ai = 0; ai < 2; ++ai)
#pragma unroll
            for (int m = 0; m < 4; ++m) {
                const int row = row0 + ai * HALF + m * 16;
                bool st = false; size_t sidx = 0;
                if (side) {
                    if (row < MP) { const int t = row & (SEQ - 1); st = t >= SEQ - WIN; sidx = (side == 1 ? OUT_KP : OUT_VP) + (size_t)((row >> 11) * WIN + (t - (SEQ - WIN))) * DKV; }
                    else { const int s = row - MP; st = true; sidx = (side == 1 ? OUT_KS : OUT_VS) + (size_t)((s >> 3) * WIN + (WIN - DSEQ) + (s & 7)) * DKV; }
                }
#pragma unroll
                for (int bj = 0; bj < 2; ++bj) {
                    f32x4 v0 = acc[ai][bj][m][0], v1 = acc[ai][bj][m][1];
                    if (st) { *(f32x4*)(out + sidx + bj * HALF + cl) = v0; *(f32x4*)(out + sidx + bj * HALF + cl + 4) = v1; }
                    if (sig) {
#pragma unroll
                        for (int j = 0; j < 4; ++j) { v0[j] = fsigmoid(v0[j]); v1[j] = fsigmoid(v1[j]); }
                    } else { v0 = v0 * sc; v1 = v1 * sc; }
                    *(u32x4*)(dst + (size_t)row * ld + col0 + bj * HALF + cl) = pack8(v0, v1);
                }
            }
    }
};
enum { K_MIX0 = 0, K_MIX1 = 1, K_WO = 2, K_GU = 3, K_DN0 = 4, K_DN1 = 5 };
struct SU { int kind, pm, pn; };
struct SParams { const char* a; const char* b; int nt; unsigned pitch2; unsigned* dep; unsigned need; unsigned* pub; };
struct StreamCtx {
    const char *ACONV, *ATT, *WC, *WA, *MERGED, *WO, *HB, *WGU, *ACT1, *ACT2, *WD; unsigned* cnt;
};
constexpr int ACT_SPLIT_PM = 22;
constexpr int CNT_MIX = 0, CNT_WO = 1, CNT_GU = 2, CNT_DN = 3;
struct StreamSched {
    int x, r; StreamCtx c;
    __device__ __forceinline__ static void tile8(int x, int t, int& pm, int& pn) {
        if (t < 32) { pm = x + 8 * (t & 3); pn = t >> 2; } else { const int s = 4 * x + (t - 32); pm = 32 + (s >> 3); pn = s & 7; } }
    __device__ __forceinline__ bool next(int k, SU& u) const {
        const int nmix = (r < 4) ? 2 : 1;
        int e, aux = 0;
        if (k < 2 * nmix) { e = r + 32 * (k >> 1); aux = k & 1; } else e = r + 32 * (k - nmix);
        if (e >= 342) return false;
        if (e < 36) { u.kind = aux ? K_MIX1 : K_MIX0; tile8(x, e, u.pm, u.pn); }
        else if (e < 72) { u.kind = K_WO; tile8(x, e - 36, u.pm, u.pn); }
        else if (e < 270) { const int q = e - 72; u.kind = K_GU;
            if (q < 160) { const int w = q & 31; u.pm = x + 8 * (w & 3); u.pn = 8 * (q >> 5) + (w >> 2); }
            else if (q < 176) { const int w = q - 160; u.pm = x + 8 * (w & 3); u.pn = 40 + (w >> 2); }
            else { const int sidx = 22 * x + (q - 176); u.pm = 32 + sidx / 44; u.pn = sidx % 44; } }
        else { const int q = e - 270, t = q >> 1; u.kind = (q & 1) ? K_DN1 : K_DN0;
            if (t < 32) { u.pm = x + 8 * (t >> 3); u.pn = t & 7; } else tile8(x, t, u.pm, u.pn); }
        return true;
    }
    __device__ __forceinline__ void params(const SU& u, SParams& p) const {
        p.dep = nullptr; p.need = 0; p.pub = nullptr;
        switch (u.kind) {
        case K_MIX0: p.a = c.ACONV + (size_t)u.pm * (256 * DC * 2); p.b = c.WC + (size_t)u.pn * (256 * DC * 2); p.nt = DC / 64; p.pitch2 = DC * 2; break;
        case K_MIX1: p.a = c.ATT + (size_t)u.pm * (256 * DA * 2); p.b = c.WA + (size_t)u.pn * (256 * DA * 2); p.nt = DA / 64; p.pitch2 = DA * 2; p.pub = c.cnt + (CNT_MIX * 36 + u.pm) * 64; break;
        case K_WO: p.a = c.MERGED + (size_t)u.pm * (256 * D * 2); p.b = c.WO + (size_t)u.pn * (256 * D * 2); p.nt = D / 64; p.pitch2 = D * 2;
            p.dep = c.cnt + (CNT_MIX * 36 + u.pm) * 64; p.need = 64; p.pub = c.cnt + (CNT_WO * 36 + u.pm) * 64; break;
        case K_GU: p.a = c.HB + (size_t)u.pm * (256 * D * 2); p.b = c.WGU + (size_t)u.pn * (256 * D * 2); p.nt = D / 64; p.pitch2 = D * 2;
            p.dep = c.cnt + (CNT_WO * 36 + u.pm) * 64; p.need = 64; p.pub = c.cnt + (CNT_GU * 36 + u.pm) * 64; break;
        default: { const int h = (u.kind == K_DN1);
            p.a = (u.pm < ACT_SPLIT_PM ? c.ACT1 + (size_t)u.pm * (256 * FF * 2) : c.ACT2 + (size_t)(u.pm - ACT_SPLIT_PM) * (256 * FF * 2)) + h * (FF);
            p.b = c.WD + (size_t)u.pn * (256 * FF * 2) + h * (FF); p.nt = FF / 128; p.pitch2 = FF * 2;
            p.dep = c.cnt + (CNT_GU * 36 + u.pm) * 64; p.need = 352; p.pub = c.cnt + (CNT_DN * 36 + u.pm) * 64; } break;
        }
    }
};
__device__ __forceinline__ bool stream_poll_once(unsigned* dep, unsigned need) {
    const bool ok = (unsigned)__builtin_amdgcn_readfirstlane(__hip_atomic_load(dep, __ATOMIC_RELAXED, __HIP_MEMORY_SCOPE_AGENT)) >= need;
    if (ok) { __builtin_amdgcn_fence(__ATOMIC_ACQUIRE, "agent"); asm volatile("s_waitcnt vmcnt(0)" ::: "memory"); }
    return ok;
}
__device__ __forceinline__ void stream_poll_block(unsigned* dep, unsigned need, unsigned* tmo) {
    unsigned spins = 0;
    while ((unsigned)__builtin_amdgcn_readfirstlane(__hip_atomic_load(dep, __ATOMIC_RELAXED, __HIP_MEMORY_SCOPE_AGENT)) < need) {
        __builtin_amdgcn_s_sleep(2);
        if ((++spins & 1023u) == 0u) { if (__hip_atomic_load(tmo, __ATOMIC_RELAXED, __HIP_MEMORY_SCOPE_AGENT) != 0u) break; if (spins > (1u << 21)) { __hip_atomic_store(tmo, 1u, __ATOMIC_RELAXED, __HIP_MEMORY_SCOPE_AGENT); break; } }
    }
    __builtin_amdgcn_fence(__ATOMIC_ACQUIRE, "agent"); asm volatile("s_waitcnt vmcnt(0)" ::: "memory");
}
__device__ __forceinline__ __amdgpu_buffer_rsrc_t mk_rsrc(const void* p) { return __builtin_amdgcn_make_buffer_rsrc(const_cast<void*>(p), 0, 0x7fffffff, 0x00020000); }
__device__ __forceinline__ void st16_wt(__amdgpu_buffer_rsrc_t rs, unsigned off, u32x4 v) { __builtin_amdgcn_raw_buffer_store_b128(v, rs, off, 0, 16); }

struct EpiStream {
    bf16_t *SG1, *SG2;
    const float *xp, *xs; float* H; float* rowss; bf16_t *ACT1, *ACT2;
    __device__ __forceinline__ bool keep(const SU& u) const { return u.kind == K_MIX0; }
    __device__ __forceinline__ void operator()(f32x4 (&acc)[2][2][4][2], const SU& u, int wr, int wc, int fr, int fq) const {
        const int row0 = u.pm * BM + wr * 64 + fr, cl = wc * 32 + 8 * fq;
        if (u.kind == K_MIX0) {
            const size_t o0 = (size_t)row0 * D + u.pn * BM + cl; const bf16_t* g2 = SG2 + o0; const bf16_t* g1 = SG1 + o0;
#pragma unroll
            for (int s = 0; s < 8; ++s) { const int ai = s >> 2, m = s & 3; const size_t off = (size_t)(ai * HALF + m * 16) * D;
#pragma unroll
                for (int bj = 0; bj < 2; ++bj) {
                    f32x4 a0, a1, c0, c1; unpack8(*(const u32x4*)(g2 + off + bj * HALF), a0, a1); unpack8(*(const u32x4*)(g1 + off + bj * HALF), c0, c1);
#pragma unroll
                    for (int j = 0; j < 4; ++j) { acc[ai][bj][m][0][j] *= c0[j] * __builtin_amdgcn_rcpf(fmaxf(a0[j], 1e-30f)); acc[ai][bj][m][1][j] *= c1[j] * __builtin_amdgcn_rcpf(fmaxf(a1[j], 1e-30f)); }
                } }
        } else if (u.kind == K_MIX1) {
            const size_t o0 = (size_t)row0 * D + u.pn * BM + cl; const bf16_t* g2 = SG2 + o0;
            const __amdgpu_buffer_rsrc_t rs = mk_rsrc(SG1); const unsigned ob = (unsigned)o0 * 2u;
            u32x4 gv[2][2];
            gv[0][0] = *(const u32x4*)(g2); gv[0][1] = *(const u32x4*)(g2 + HALF);
#pragma unroll
            for (int s = 0; s < 8; ++s) { const int ai = s >> 2, m = s & 3; const unsigned off = (unsigned)(ai * HALF + m * 16) * D;
                if (s + 1 < 8) { const size_t off2 = (size_t)(((s + 1) >> 2) * HALF + ((s + 1) & 3) * 16) * D;
                    gv[(s + 1) & 1][0] = *(const u32x4*)(g2 + off2); gv[(s + 1) & 1][1] = *(const u32x4*)(g2 + off2 + HALF); }
#pragma unroll
                for (int bj = 0; bj < 2; ++bj) { f32x4 a0, a1; unpack8(gv[s & 1][bj], a0, a1);
                    st16_wt(rs, ob + (off + bj * HALF) * 2u, pack8(acc[ai][bj][m][0] * a0, acc[ai][bj][m][1] * a1)); }
            }
        } else if (u.kind == K_WO) {
            const size_t o0 = (size_t)row0 * D + u.pn * BM + cl;
            const float* xb = ((u.pm < MP / BM) ? xp : xs - (size_t)MP * D) + o0;
            const __amdgpu_buffer_rsrc_t rb = mk_rsrc(SG2); const unsigned obf = (unsigned)o0 * 2u;
            float* rsum = rowss + row0;
            f32x4 xv[2][4];
#define WO_LD(s_, buf_) do { const size_t o_ = (size_t)(((s_) >> 2) * HALF + ((s_) & 3) * 16) * D; \
            xv[buf_][0] = *(const f32x4*)(xb + o_); xv[buf_][1] = *(const f32x4*)(xb + o_ + 4); xv[buf_][2] = *(const f32x4*)(xb + o_ + HALF); xv[buf_][3] = *(const f32x4*)(xb + o_ + HALF + 4); } while (0)
            WO_LD(0, 0);
#pragma unroll
            for (int s = 0; s < 8; ++s) { const int ai = s >> 2, m = s & 3; const unsigned off = (unsigned)(ai * HALF + m * 16) * D;
                if (s + 1 < 8) WO_LD(s + 1, (s + 1) & 1);
                const f32x4 h00 = xv[s & 1][0] + acc[ai][0][m][0], h01 = xv[s & 1][1] + acc[ai][0][m][1], h10 = xv[s & 1][2] + acc[ai][1][m][0], h11 = xv[s & 1][3] + acc[ai][1][m][1];
                st16_wt(rb, obf + off * 2u, pack8(h00, h01)); st16_wt(rb, obf + (off + HALF) * 2u, pack8(h10, h11));
                float ss = (h00[0] * h00[0] + h00[1] * h00[1]) + (h00[2] * h00[2] + h00[3] * h00[3]) + (h01[0] * h01[0] + h01[1] * h01[1]) + (h01[2] * h01[2] + h01[3] * h01[3])
                         + (h10[0] * h10[0] + h10[1] * h10[1]) + (h10[2] * h10[2] + h10[3] * h10[3]) + (h11[0] * h11[0] + h11[1] * h11[1]) + (h11[2] * h11[2] + h11[3] * h11[3]);
                ss += __shfl_xor(ss, 16); ss += __shfl_xor(ss, 32);
                if (fq == 0) __hip_atomic_fetch_add(rsum + ai * HALF + m * 16, ss, __ATOMIC_RELAXED, __HIP_MEMORY_SCOPE_AGENT);
            }
#undef WO_LD
        } else if (u.kind == K_GU) {
            const int ch = 128 * u.pn + cl;
            float rstd[8];
#pragma unroll
            for (int s = 0; s < 8; ++s) rstd[s] = __hip_atomic_load(rowss + row0 + (s >> 2) * HALF + (s & 3) * 16, __ATOMIC_RELAXED, __HIP_MEMORY_SCOPE_AGENT);
#pragma unroll
            for (int s = 0; s < 8; ++s) rstd[s] = __builtin_amdgcn_rsqf(rstd[s] * (1.0f / D) + EPS);
            const bool lo = u.pm < ACT_SPLIT_PM;
            const __amdgpu_buffer_rsrc_t ra = mk_rsrc(lo ? ACT1 : ACT2);
            const unsigned oa = (unsigned)(((size_t)(row0 - (lo ? 0 : ACT_SPLIT_PM * BM)) * FF + ch) * 2);
#pragma unroll
            for (int s = 0; s < 8; ++s) { const int ai = s >> 2, m = s & 3; const float rr = rstd[s];
                f32x4 o[2];
#pragma unroll
                for (int n = 0; n < 2; ++n)
#pragma unroll
                    for (int j = 0; j < 4; ++j) { const float g = acc[ai][0][m][n][j] * rr, up = acc[ai][1][m][n][j] * rr; o[n][j] = g * fsigmoid(g) * up; }
                st16_wt(ra, oa + (unsigned)(ai * HALF + m * 16) * (FF * 2), pack8(o[0], o[1]));
            }
        } else if (u.kind == K_DN0) {
            const size_t o0 = (size_t)row0 * D + u.pn * BM + cl;
            const bf16_t* hb = SG2 + o0; const __amdgpu_buffer_rsrc_t rh = mk_rsrc(SG2); const unsigned oh = (unsigned)o0 * 2u;
            u32x4 hv[2][2];
            hv[0][0] = *(const u32x4*)(hb); hv[0][1] = *(const u32x4*)(hb + HALF);
#pragma unroll
            for (int s = 0; s < 8; ++s) { const int ai = s >> 2, m = s & 3; const unsigned off = (unsigned)(ai * HALF + m * 16) * D;
                if (s + 1 < 8) { const size_t off2 = (size_t)(((s + 1) >> 2) * HALF + ((s + 1) & 3) * 16) * D;
                    hv[(s + 1) & 1][0] = *(const u32x4*)(hb + off2); hv[(s + 1) & 1][1] = *(const u32x4*)(hb + off2 + HALF); }
#pragma unroll
                for (int bj = 0; bj < 2; ++bj) { f32x4 a0, a1; unpack8(hv[s & 1][bj], a0, a1);
                    st16_wt(rh, oh + (off + bj * HALF) * 2u, pack8(a0 + acc[ai][bj][m][0], a1 + acc[ai][bj][m][1])); }
            }
        } else {
            const __amdgpu_buffer_rsrc_t rp = mk_rsrc(SG1); const unsigned op = (unsigned)((size_t)row0 * D + u.pn * BM + cl) * 2u;
#pragma unroll
            for (int s = 0; s < 8; ++s) { const int ai = s >> 2, m = s & 3; const unsigned off = (unsigned)(ai * HALF + m * 16) * D;
#pragma unroll
                for (int bj = 0; bj < 2; ++bj) st16_wt(rp, op + (off + bj * HALF) * 2u, pack8(acc[ai][bj][m][0], acc[ai][bj][m][1])); }
        }
    }
};

template <class Epi, class Sched>
__device__ __forceinline__ void gemm_stream(LAS unsigned char* lds, volatile LAS unsigned* flagw, const Sched& S, const Epi& E, unsigned* tmo) {
    const int tid = threadIdx.x, wid = __builtin_amdgcn_readfirstlane(tid >> 6), lane = tid & 63, wr = wid >> 2, wc = wid & 3, fr = lane & 15, fq = lane >> 4;
    int R0, C0; stage_rc(tid * 16, R0, C0); const int Rb0 = (R0 & ~31) + perm32(R0 & 31);
    const size_t kstep = (size_t)(BK * 2);
    const unsigned ldsw = (unsigned)wid * 1024u;
    const int aoff = lds_byte(wr * 64 + fr, fq * 8), boff = lds_byte(wc * 32 + fr, fq * 8);
#define PG8_SA(b, h) (((b) * 2 + (h)) * HTB)
#define PG8_SB(b, h) ((4 + (b) * 2 + (h)) * HTB)
#define PG8_STAGE(bufoff, gbase, voff, rstep) do { \
        __builtin_amdgcn_global_load_lds((const unsigned*)((const char*)(gbase) + (voff)), (LAS unsigned*)(lds + (bufoff) + ldsw), 16, 0, 0); \
        __builtin_amdgcn_global_load_lds((const unsigned*)((const char*)(gbase) + (rstep) + (voff)), (LAS unsigned*)(lds + (bufoff) + ldsw + 8192), 16, 0, 0); } while (0)
#define PG8_LDA(dst, b, h) do { _Pragma("unroll") for (int m = 0; m < 4; ++m) _Pragma("unroll") for (int k = 0; k < 2; ++k) dst[m][k] = *(const LAS bf16x8*)(lds + PG8_SA(b, h) + aoff + m * 2048 + k * 1024); } while (0)
#define PG8_LDB(dst, b, h) do { _Pragma("unroll") for (int n = 0; n < 2; ++n) _Pragma("unroll") for (int k = 0; k < 2; ++k) dst[n][k] = *(const LAS bf16x8*)(lds + PG8_SB(b, h) + boff + n * 2048 + k * 1024); } while (0)
#define PG8_MMA(ai, bj, At, Bt) do { __builtin_amdgcn_s_setprio(1); _Pragma("unroll") for (int m = 0; m < 4; ++m) _Pragma("unroll") for (int n = 0; n < 2; ++n) _Pragma("unroll") for (int k = 0; k < 2; ++k) \
        acc[ai][bj][m][n] = __builtin_amdgcn_mfma_f32_16x16x32_bf16(Bt[n][k], At[m][k], acc[ai][bj][m][n], 0, 0, 0); __builtin_amdgcn_s_setprio(0); } while (0)
#define PG8_WAIT_V(n) asm volatile("s_waitcnt vmcnt(" #n ")" ::: "memory")
#define PG8_WAIT_L(n) asm volatile("s_waitcnt lgkmcnt(" #n ")" ::: "memory")
#define PG8_BAR __builtin_amdgcn_s_barrier()
#define PG8_SCHED __builtin_amdgcn_sched_barrier(0)
#define PG8_ZERO_ACC() do { _Pragma("unroll") for (int a = 0; a < 2; ++a) _Pragma("unroll") for (int b = 0; b < 2; ++b) _Pragma("unroll") for (int m = 0; m < 4; ++m) _Pragma("unroll") for (int n = 0; n < 2; ++n) acc[a][b][m][n] = (f32x4){0.f, 0.f, 0.f, 0.f}; } while (0)
    SU cur, nxt; SParams pc, pq; int ui = 0;
    if (!S.next(0, cur)) return;
    S.params(cur, pc);
    f32x4 acc[2][2][4][2];
    PG8_ZERO_ACC();
    bf16x8 At[4][2], B0[2][2], B1[2][2];
    unsigned known0 = 0u, known1 = 0u, known2 = 0u, known3 = 0u;
#define PG8_KNOWN(idx) ((((idx) < 32 ? known0 : (idx) < 64 ? known1 : (idx) < 96 ? known2 : known3) >> ((idx) & 31)) & 1u)
#define PG8_SETKNOWN(idx) do { const unsigned b_ = 1u << ((idx) & 31); if ((idx) < 32) known0 |= b_; else if ((idx) < 64) known1 |= b_; else if ((idx) < 96) known2 |= b_; else known3 |= b_; } while (0)
    for (;;) {
        if (pc.dep) {
            const int didx = (int)(pc.dep - S.c.cnt) >> 6;
            if (!PG8_KNOWN(didx)) {
                if (wid == 0) stream_poll_block(pc.dep, pc.need, tmo);
                PG8_BAR;
                PG8_SETKNOWN(didx);
            }
        }
        const char* cA = pc.a; const char* cB = pc.b; int nt = pc.nt;
        unsigned vAc = (unsigned)R0 * pc.pitch2 + (unsigned)C0 * 2u, vBc = (unsigned)Rb0 * pc.pitch2 + (unsigned)C0 * 2u;
        size_t rsc = (size_t)64 * pc.pitch2, hsc = (size_t)HALF * pc.pitch2;
        unsigned* pend = nullptr;
        PG8_STAGE(PG8_SB(0, 0), cB, vBc, rsc); PG8_STAGE(PG8_SB(0, 1), cB + hsc, vBc, rsc); PG8_STAGE(PG8_SA(0, 0), cA, vAc, rsc); PG8_STAGE(PG8_SA(0, 1), cA + hsc, vAc, rsc);
        if (wr == 1) PG8_BAR;
        PG8_WAIT_V(2); PG8_BAR;
        PG8_STAGE(PG8_SB(1, 0), cB + kstep, vBc, rsc); PG8_STAGE(PG8_SA(1, 0), cA + kstep, vAc, rsc); PG8_STAGE(PG8_SB(1, 1), cB + hsc + kstep, vBc, rsc);
        PG8_WAIT_V(6); PG8_BAR;
        bool has_next, chain;
        for (;;) {
            has_next = S.next(ui + 1, nxt);
            if (has_next) S.params(nxt, pq); else pq = pc;
            chain = has_next;
            const char* nA = cA; const char* nB = cB; unsigned vAn = vAc, vBn = vBc; size_t rsn = rsc, hsn = hsc;
            for (int t = 0; t < nt; t += 2) {
                const bool last = (t == nt - 2);
                if (last && has_next) {
                    if (pq.dep) {
                        const int didx = (int)(pq.dep - S.c.cnt) >> 6;
                        if (!PG8_KNOWN(didx)) {
                            if (wid == 0) { const bool ok = stream_poll_once(pq.dep, pq.need); if (lane == 0) *flagw = ok ? 1u : 0u; asm volatile("s_waitcnt lgkmcnt(0)" ::: "memory"); }
                            PG8_BAR;
                            chain = (*flagw != 0u);
                            if (chain) PG8_SETKNOWN(didx);
                        }
                    }
                    if (chain) { nA = pq.a; nB = pq.b; vAn = (unsigned)R0 * pq.pitch2 + (unsigned)C0 * 2u; vBn = (unsigned)Rb0 * pq.pitch2 + (unsigned)C0 * 2u; rsn = (size_t)64 * pq.pitch2; hsn = (size_t)HALF * pq.pitch2; }
                }
                const char* a1 = cA + (size_t)(t + 1) * kstep;
                const char* a2 = last ? nA : cA + (size_t)(t + 2) * kstep; const char* b2 = last ? nB : cB + (size_t)(t + 2) * kstep;
                const char* a3 = a2 + kstep; const char* b3 = b2 + kstep;
                const unsigned vA2 = last ? vAn : vAc, vB2 = last ? vBn : vBc; const size_t rs2 = last ? rsn : rsc, hs2 = last ? hsn : hsc;
                PG8_LDB(B0, 0, 0); PG8_LDB(B1, 0, 1); PG8_SCHED; PG8_LDA(At, 0, 0); PG8_STAGE(PG8_SA(1, 1), a1 + hsc, vAc, rsc);
                PG8_WAIT_V(8); PG8_WAIT_L(0); PG8_BAR; PG8_MMA(0, 0, At, B0); PG8_MMA(0, 1, At, B1); PG8_BAR; PG8_SCHED;
                PG8_LDA(At, 0, 1); PG8_STAGE(PG8_SB(0, 0), b2, vB2, rs2); PG8_STAGE(PG8_SB(0, 1), b2 + hs2, vB2, rs2); PG8_STAGE(PG8_SA(0, 0), a2, vA2, rs2);
                PG8_WAIT_V(8); PG8_WAIT_L(0); PG8_BAR; PG8_MMA(1, 0, At, B0); PG8_MMA(1, 1, At, B1); PG8_BAR; PG8_SCHED;
                PG8_LDB(B0, 1, 0); PG8_LDB(B1, 1, 1); PG8_SCHED; PG8_LDA(At, 1, 0); PG8_STAGE(PG8_SA(0, 1), a2 + hs2, vA2, rs2);
                PG8_WAIT_V(8); PG8_WAIT_L(0); PG8_BAR; PG8_MMA(0, 0, At, B0); PG8_MMA(0, 1, At, B1); PG8_BAR; PG8_SCHED;
                PG8_LDA(At, 1, 1); PG8_STAGE(PG8_SB(1, 0), b3, vB2, rs2); PG8_STAGE(PG8_SB(1, 1), b3 + hs2, vB2, rs2); PG8_STAGE(PG8_SA(1, 0), a3, vA2, rs2);
                PG8_WAIT_V(8); PG8_WAIT_L(0); PG8_BAR; PG8_MMA(1, 0, At, B0); PG8_MMA(1, 1, At, B1); PG8_BAR; PG8_SCHED;
                if (t == 0 && pend) { if (lane == 0) __hip_atomic_fetch_add(pend, 1u, __ATOMIC_RELAXED, __HIP_MEMORY_SCOPE_AGENT); pend = nullptr; }
            }
            if (wr == 0) PG8_BAR;
            E(acc, cur, wr, wc, fr, fq);
            pend = pc.pub;
            if (!chain) break;
            if (!E.keep(cur)) PG8_ZERO_ACC();
            cur = nxt; pc = pq; cA = nA; cB = nB; nt = pc.nt; vAc = vAn; vBc = vBn; rsc = rsn; hsc = hsn; ++ui;
            if (wr == 1) PG8_BAR;
        }
        PG8_WAIT_V(0);
        if (pend && lane == 0) __hip_atomic_fetch_add(pend, 1u, __ATOMIC_RELAXED, __HIP_MEMORY_SCOPE_AGENT);
        PG8_BAR;
        if (!has_next) break;
        PG8_ZERO_ACC();
        cur = nxt; pc = pq; ++ui;
    }
#undef PG8_SA
#undef PG8_SB
#undef PG8_STAGE
#undef PG8_LDA
#undef PG8_LDB
#undef PG8_MMA
#undef PG8_WAIT_V
#undef PG8_WAIT_L
#undef PG8_BAR
#undef PG8_SCHED
#undef PG8_ZERO_ACC
#undef PG8_KNOWN
#undef PG8_SETKNOWN
}
}

#define XB_TMO      128
#define XB_XCNT(j)  (256  + 64 * (j))
#define XB_XSUB(j)  (1280 + 64 * (j))
#define XB_XGEN(j)  (2304 + 64 * (j))
#define XB_TOP      3328
#define XB_TOPGEN   3392
#define XCD_BAR_WORDS 3456
#define XB_SPIN_CAP (1u << 18)
__device__ __forceinline__ unsigned xb_ld(unsigned* p)              { return __hip_atomic_load(p, __ATOMIC_RELAXED, __HIP_MEMORY_SCOPE_AGENT); }
__device__ __forceinline__ unsigned xb_add(unsigned* p, unsigned v) { return __hip_atomic_fetch_add(p, v, __ATOMIC_RELAXED, __HIP_MEMORY_SCOPE_AGENT); }
__device__ __forceinline__ unsigned xb_xcc_id() { return (unsigned)__builtin_amdgcn_s_getreg((3 << 11) | 20) & 0xFu; }
#define XB_SPIN(cond, bar) do { unsigned _sp = 0; while (cond) { __builtin_amdgcn_s_sleep(1); \
    if ((++_sp & 255u) == 0u) { if (xb_ld(&(bar)[XB_TMO])) break; if (_sp > XB_SPIN_CAP) { atomicAdd(&(bar)[XB_TMO], 1u); break; } } } } while (0)
struct XcdBarrier { unsigned* bar; unsigned x; volatile LAS unsigned* st; };
__device__ __forceinline__ XcdBarrier xcd_barrier_post(unsigned* bar, volatile LAS unsigned* st) {
    XcdBarrier b; b.bar = bar; b.x = xb_xcc_id(); b.st = st;
    if (threadIdx.x == 0) (void)xb_add(&bar[XB_XCNT(b.x)], 1u);
    return b;
}
__device__ __forceinline__ void xcd_barrier_complete(unsigned* bar, unsigned x, unsigned& nloc, unsigned& nx) {
    const unsigned G = gridDim.x * gridDim.y * gridDim.z;
    unsigned sum, cnt, mine, sp = 0u;
    for (;;) {
        sum = 0u; cnt = 0u; mine = 0u;
#pragma unroll
        for (unsigned j = 0; j < 16; ++j) { const unsigned c = xb_ld(&bar[XB_XCNT(j)]); sum += c; cnt += (c > 0u) ? 1u : 0u; mine = (j == x) ? c : mine; }
        if (sum == G) break;
        __builtin_amdgcn_s_sleep(1);
        if ((++sp & 255u) == 0u) { if (xb_ld(&bar[XB_TMO])) break; if (sp > XB_SPIN_CAP) { atomicAdd(&bar[XB_TMO], 1u); break; } }
    }
    nloc = mine > 0u ? mine : 1u; nx = cnt > 0u ? cnt : 1u;
}
__device__ __forceinline__ void xcd_barrier(const XcdBarrier& b) {
    asm volatile("s_waitcnt vmcnt(0)" ::: "memory");
    __syncthreads();
    if (threadIdx.x == 0) {
        unsigned* bar = b.bar;
        __builtin_amdgcn_s_waitcnt(0);
        unsigned nloc = b.st[0], nx = b.st[1];
        if (nloc == 0u) { xcd_barrier_complete(bar, b.x, nloc, nx); b.st[0] = nloc; b.st[1] = nx; }
        const unsigned old = xb_add(&bar[XB_XSUB(b.x)], 1u);
        const unsigned gen = old / nloc;
        if (old + 1u == (gen + 1u) * nloc) {
            __builtin_amdgcn_fence(__ATOMIC_RELEASE, "agent");
            asm volatile("s_waitcnt vmcnt(0)" ::: "memory");
            const unsigned og = xb_add(&bar[XB_TOP], 1u);
            const unsigned tg = og / nx;
            if (og + 1u == (tg + 1u) * nx) xb_add(&bar[XB_TOPGEN], 1u);
            else XB_SPIN(xb_ld(&bar[XB_TOPGEN]) == tg, bar);
            __builtin_amdgcn_fence(__ATOMIC_ACQUIRE, "agent");
            xb_add(&bar[XB_XGEN(b.x)], 1u);
            asm volatile("s_waitcnt vmcnt(0)" ::: "memory");
        } else {
            XB_SPIN(xb_ld(&bar[XB_XGEN(b.x)]) == gen, bar);
            __builtin_amdgcn_fence(__ATOMIC_ACQUIRE, "agent");
            asm volatile("s_waitcnt vmcnt(0)" ::: "memory");
        }
    }
    __syncthreads();
}

struct Args {
    const float *x_prompt, *x_sample, *cache_k, *cache_v, *state_conv, *rel_bias, *w_in, *w_conv, *w_conv_out, *sinks, *w_attn_out, *w_o, *g_mix, *g_ffn, *w_gate, *w_up, *w_down, *g_final;
    float* out; unsigned char* ws; int ph_lo, ph_hi;
};
struct Frame { LAS unsigned char* lds; int tid, lane, wave, vcu, G; };

static __device__ const unsigned char T5_BUCKET[128] = {
    0, 1, 2, 3, 4, 5, 6, 7, 8, 9, 10, 11, 12, 13, 14, 15, 16, 16, 16, 17, 17, 18, 18, 18, 19, 19, 19, 20, 20, 20, 20, 21, 21, 21, 21, 22, 22, 22, 22, 22, 23, 23, 23, 23, 23, 23,
    24, 24, 24, 24, 24, 24, 25, 25, 25, 25, 25, 25, 25, 26, 26, 26, 26, 26, 26, 26, 26, 27, 27, 27, 27, 27, 27, 27, 27, 27, 27, 28, 28, 28, 28, 28, 28, 28, 28, 28, 28,
    29, 29, 29, 29, 29, 29, 29, 29, 29, 29, 29, 29, 30, 30, 30, 30, 30, 30, 30, 30, 30, 30, 30, 30, 30, 30, 31, 31, 31, 31, 31, 31, 31, 31, 31, 31, 31, 31, 31, 31, 31};

constexpr int P0_PITCH = 520;
struct P0Item { const float* W; bf16_t* WT; const float* gk; int K, N, k0, n0, dr; };
__device__ __forceinline__ bool p0_decode(const Args& a, unsigned char* ws, int it, P0Item& q) {
    constexpr int T_IN = (D / 128) * (NIN / 128), T_C = (DC / 128) * (D / 128), T_A = T_C, T_O = (D / 128) * (D / 128), T_G = (D / 128) * (FF / 128), T_U = T_G, T_D = (FF / 128) * (D / 128);
    int r = it; q.gk = nullptr;
    if (r < T_IN) { const int nb = NIN / 128; q.W = a.w_in; q.WT = (bf16_t*)(ws + WS_WIN); q.K = D; q.N = NIN; q.k0 = 128 * (r / nb); q.n0 = 128 * (r % nb);
        const int n0 = q.n0; q.dr = n0 < 1024 ? n0 : n0 < 2048 ? 1024 + 2 * (n0 - 1024) : n0 < 3072 ? 1024 + 2 * (n0 - 2048) + 128 : n0; return true; } r -= T_IN;
    if (r < T_C) { const int nb = D / 128; q.W = a.w_conv_out; q.WT = (bf16_t*)(ws + WS_WC); q.K = DC; q.N = D; q.k0 = 128 * (r / nb); q.n0 = 128 * (r % nb); q.dr = q.n0; return true; } r -= T_C;
    if (r < T_A) { const int nb = D / 128; q.W = a.w_attn_out; q.WT = (bf16_t*)(ws + WS_WA); q.K = DA; q.N = D; q.k0 = 128 * (r / nb); q.n0 = 128 * (r % nb); q.dr = q.n0; return true; } r -= T_A;
    if (r < T_O) { const int nb = D / 128; q.W = a.w_o; q.WT = (bf16_t*)(ws + WS_WO); q.K = D; q.N = D; q.k0 = 128 * (r / nb); q.n0 = 128 * (r % nb); q.dr = q.n0; return true; } r -= T_O;
    if (r < T_G) { const int nb = FF / 128; q.W = a.w_gate; q.WT = (bf16_t*)(ws + WS_WGU); q.gk = a.g_ffn; q.K = D; q.N = FF; q.k0 = 128 * (r / nb); q.n0 = 128 * (r % nb); q.dr = 2 * q.n0; return true; } r -= T_G;
    if (r < T_U) { const int nb = FF / 128; q.W = a.w_up; q.WT = (bf16_t*)(ws + WS_WGU); q.gk = a.g_ffn; q.K = D; q.N = FF; q.k0 = 128 * (r / nb); q.n0 = 128 * (r % nb); q.dr = 2 * q.n0 + 128; return true; } r -= T_U;
    if (r < T_D) { const int nb = D / 128; q.W = a.w_down; q.WT = (bf16_t*)(ws + WS_WD); q.K = FF; q.N = D; q.k0 = 128 * (r / nb); q.n0 = 128 * (r % nb); q.dr = q.n0; return true; }
    return false;
}
__device__ __forceinline__ void p0_load(const P0Item& q, int tid, f32x4 (&v)[8]) {
    const int c4 = tid & 31, kr = tid >> 5;
#pragma unroll
    for (int i = 0; i < 4; ++i) { const int k = q.k0 + 2 * (kr + 16 * i); const float* p = q.W + (size_t)k * q.N + q.n0 + 4 * c4;
        v[2 * i] = *(const f32x4*)p; v[2 * i + 1] = *(const f32x4*)(p + q.N);
        if (q.gk) { const float g0 = q.gk[k], g1 = q.gk[k + 1]; v[2 * i] = v[2 * i] * g0; v[2 * i + 1] = v[2 * i + 1] * g1; } }
}
__device__ __forceinline__ void p0_prologue(const Frame& F, const Args& a) {
    unsigned char* ws = a.ws;
    LAS unsigned char* T2 = F.lds;
    const int tid = F.tid;
    constexpr int NITEMS = (D / 128) * (NIN / 128) + 2 * (DC / 128) * (D / 128) + (D / 128) * (D / 128) + 2 * (D / 128) * (FF / 128) + (FF / 128) * (D / 128);
    { float* rs = (float*)((unsigned*)(ws + WS_CTL) + CW_ROWSS); for (int i = F.vcu * (NWAVES * 64) + tid; i < M; i += F.G * (NWAVES * 64)) rs[i] = 0.f;
      if (blockIdx.x == 0 && tid < 4 * 36) ((unsigned*)(ws + WS_CTL))[CW_CNT + tid * 64] = 0u;
      if (blockIdx.x == 0 && tid == 4 * 36) ((unsigned*)(ws + WS_CTL))[CW_TICKET] = 0u; }
    P0Item q, qn; f32x4 v[8];
    int it = F.vcu; bool have = p0_decode(a, ws, it, q);
    if (have) p0_load(q, tid, v);
    while (have) {
        { const int c4 = tid & 31, kr = tid >> 5;
#pragma unroll
          for (int i = 0; i < 4; ++i) { u32x4 w; w.x = cvt_pk_bf16(v[2 * i][0], v[2 * i + 1][0]); w.y = cvt_pk_bf16(v[2 * i][1], v[2 * i + 1][1]); w.z = cvt_pk_bf16(v[2 * i][2], v[2 * i + 1][2]); w.w = cvt_pk_bf16(v[2 * i][3], v[2 * i + 1][3]);
              LAS unsigned char* tp = T2 + (kr + 16 * i) * P0_PITCH + c4 * 16; *(LAS u32x2*)tp = (u32x2){w.x, w.y}; *(LAS u32x2*)(tp + 8) = (u32x2){w.z, w.w}; } }
        __syncthreads();
        it += F.G; const bool hn = p0_decode(a, ws, it, qn);
        if (hn) p0_load(qn, tid, v);
        { const int k8 = tid & 15, nr = tid >> 4;
#pragma unroll
          for (int i = 0; i < 4; ++i) { const int n = nr + 32 * i; LAS const unsigned char* p = T2 + (4 * k8) * P0_PITCH + n * 4;
              u32x4 o; o.x = *(LAS const unsigned*)(p); o.y = *(LAS const unsigned*)(p + P0_PITCH); o.z = *(LAS const unsigned*)(p + 2 * P0_PITCH); o.w = *(LAS const unsigned*)(p + 3 * P0_PITCH);
              *(u32x4*)(q.WT + (size_t)(q.dr + n) * q.K + q.k0 + 8 * k8) = o; } }
        __syncthreads();
        q = qn; have = hn;
    }
    const int gw = F.vcu * NWAVES + F.wave, NGW = F.G * NWAVES;
    bf16_t* XN = (bf16_t*)(ws + WS_XN);
    for (int m = gw; m < M; m += NGW) {
        const float* xrow = (m < MP) ? a.x_prompt + (size_t)m * D : a.x_sample + (size_t)(m - MP) * D;
        const f32x4* xr = (const f32x4*)xrow + F.lane; const f32x4* gr = (const f32x4*)a.g_mix + F.lane;
        f32x4 xv[8]; float s = 0.f;
#pragma unroll
        for (int j = 0; j < 8; ++j) { xv[j] = xr[64 * j]; s += (xv[j][0] * xv[j][0] + xv[j][1] * xv[j][1]) + (xv[j][2] * xv[j][2] + xv[j][3] * xv[j][3]); }
        const float rstd = __builtin_amdgcn_rsqf(wave_sum(s) * (1.0f / D) + EPS);
        u32x2* o8 = (u32x2*)(XN + (size_t)m * D) + F.lane;
#pragma unroll
        for (int j = 0; j < 8; ++j) { const f32x4 g = gr[64 * j]; u32x2 w; w.x = cvt_pk_bf16(xv[j][0] * rstd * g[0], xv[j][1] * rstd * g[1]); w.y = cvt_pk_bf16(xv[j][2] * rstd * g[2], xv[j][3] * rstd * g[3]); o8[64 * j] = w; }
    }
}

constexpr int KIMG_STRIDE = 144, VT_STRIDE = 528;
constexpr int LDS_KIMG = 0, LDS_VT = 256 * KIMG_STRIDE, LDS_LUT = LDS_VT + 64 * VT_STRIDE, LDS_SINK = LDS_LUT + 4 * 128 * 4;
static_assert(LDS_SINK + 16 <= RING_BYTES, "attention LDS");

__device__ __forceinline__ void attn_group(LAS const unsigned char* lds, const int key0, const bf16x8 q0, const bf16x8 q1, const int dist0, const int min_krow, const int hl, bf16_t* outp, const int lane) {
    const int l15 = lane & 15, g = lane >> 4;
    f32x4 s[10];
    LAS const unsigned char* kp = lds + LDS_KIMG + (key0 + l15) * KIMG_STRIDE + g * 16;
#pragma unroll
    for (int T = 0; T < 10; ++T) {
        const bf16x8 k0f = *(LAS const bf16x8*)(kp + T * 16 * KIMG_STRIDE), k1f = *(LAS const bf16x8*)(kp + T * 16 * KIMG_STRIDE + 64);
        f32x4 a = (f32x4){0.f, 0.f, 0.f, 0.f};
        a = __builtin_amdgcn_mfma_f32_16x16x32_bf16(k0f, q0, a, 0, 0, 0);
        a = __builtin_amdgcn_mfma_f32_16x16x32_bf16(k1f, q1, a, 0, 0, 0);
        s[T] = a;
    }
    LAS const float* lut = (LAS const float*)(lds + LDS_LUT) + hl * 128;
    float mx = -INFINITY;
#pragma unroll
    for (int T = 0; T < 10; ++T)
#pragma unroll
        for (int r = 0; r < 4; ++r) {
            const int kk = 16 * T + 4 * g + r, dist = dist0 - kk;
            const bool valid = ((unsigned)dist < 128u) && (key0 + kk >= min_krow);
            const float v = valid ? s[T][r] + lut[dist & 127] : -INFINITY;
            s[T][r] = v; mx = fmaxf(mx, v);
        }
    mx = fmaxf(mx, __shfl_xor(mx, 16)); mx = fmaxf(mx, __shfl_xor(mx, 32));
    const float sink = ((LAS const float*)(lds + LDS_SINK))[hl];
    mx = fmaxf(mx, sink);
    float sum = 0.f;
#pragma unroll
    for (int T = 0; T < 10; ++T)
#pragma unroll
        for (int r = 0; r < 4; ++r) { const float p = __expf(s[T][r] - mx); s[T][r] = p; sum += p; }
    sum += __shfl_xor(sum, 16); sum += __shfl_xor(sum, 32);
    sum += __expf(sink - mx);
    const float inv = 1.0f / sum;
    bf16x8 pf[5];
#pragma unroll
    for (int P = 0; P < 5; ++P) pf[P] = __builtin_bit_cast(bf16x8, pg8::pack8(s[2 * P] * inv, s[2 * P + 1] * inv));
#pragma unroll
    for (int dt = 0; dt < 4; ++dt) {
        f32x4 o = (f32x4){0.f, 0.f, 0.f, 0.f};
        LAS const unsigned char* vp = lds + LDS_VT + (16 * dt + l15) * VT_STRIDE + (key0 + 4 * g) * 2;
#pragma unroll
        for (int P = 0; P < 5; ++P) {
            const u32x2 lo = *(LAS const u32x2*)(vp + 64 * P), hi = *(LAS const u32x2*)(vp + 64 * P + 32);
            const bf16x8 vf = __builtin_bit_cast(bf16x8, (u32x4){lo.x, lo.y, hi.x, hi.y});
            o = __builtin_amdgcn_mfma_f32_16x16x32_bf16(vf, pf[P], o, 0, 0, 0);
        }
        u32x2 w; w.x = cvt_pk_bf16(o[0], o[1]); w.y = cvt_pk_bf16(o[2], o[3]);
        *(u32x2*)(outp + 16 * dt + 4 * g) = w;
    }
}

__device__ __forceinline__ void p2_attention_conv(const Frame& F, const Args& a) {
    unsigned char* ws = a.ws;
    const bf16_t* Qb = (const bf16_t*)(ws + WS_Q); const bf16_t* Kb = (const bf16_t*)(ws + WS_K); const bf16_t* Vb = (const bf16_t*)(ws + WS_V);
    bf16_t* ATT = (bf16_t*)(ws + WS_ATT);
    LAS unsigned char* lds = F.lds;
    const int tid = F.tid, lane = F.lane, wave = F.wave, l15 = lane & 15, g = lane >> 4;
    for (int u = blockIdx.x; u < NBATCH * 16 * 4; u += F.G) {
        const int b = u >> 6, nb = (u >> 2) & 15, kvh = u & 3;
        __syncthreads();
        {
            const int hl = tid >> 7, dist = tid & 127;
            ((LAS float*)(lds + LDS_LUT))[tid] = a.rel_bias[T5_BUCKET[dist] * 16 + kvh * 4 + hl];
            if (tid < 4) ((LAS float*)(lds + LDS_SINK))[tid] = a.sinks[kvh * 4 + tid];
        }
#pragma unroll
        for (int i = 0; i < 4; ++i) {
            const int id = tid + 512 * i, r = id >> 3, c8 = id & 7, t = nb * WIN - WIN + r;
            u32x4 kv = (u32x4){0u, 0u, 0u, 0u}, vv = (u32x4){0u, 0u, 0u, 0u};
            if (t >= 0) { const size_t off = (size_t)(b * SEQ + t) * DKV + kvh * 64 + c8 * 8; kv = *(const u32x4*)(Kb + off); vv = *(const u32x4*)(Vb + off); }
            *(LAS u32x4*)(lds + LDS_KIMG + r * KIMG_STRIDE + c8 * 16) = kv;
            LAS unsigned char* vt = lds + LDS_VT + (c8 * 8) * VT_STRIDE + r * 2;
            *(LAS bf16_t*)(vt + 0 * VT_STRIDE) = (bf16_t)(vv.x & 0xffffu); *(LAS bf16_t*)(vt + 1 * VT_STRIDE) = (bf16_t)(vv.x >> 16);
            *(LAS bf16_t*)(vt + 2 * VT_STRIDE) = (bf16_t)(vv.y & 0xffffu); *(LAS bf16_t*)(vt + 3 * VT_STRIDE) = (bf16_t)(vv.y >> 16);
            *(LAS bf16_t*)(vt + 4 * VT_STRIDE) = (bf16_t)(vv.z & 0xffffu); *(LAS bf16_t*)(vt + 5 * VT_STRIDE) = (bf16_t)(vv.z >> 16);
            *(LAS bf16_t*)(vt + 6 * VT_STRIDE) = (bf16_t)(vv.w & 0xffffu); *(LAS bf16_t*)(vt + 7 * VT_STRIDE) = (bf16_t)(vv.w >> 16);
        }
        __syncthreads();
        const int hl = wave >> 1, head = kvh * 4 + hl;
#pragma unroll 1
        for (int i = 0; i < 4; ++i) {
            const int qg = (wave & 1) * 4 + i, qi0 = 16 * qg, key0 = 16 * (qg & ~1);
            const size_t row = (size_t)b * SEQ + nb * WIN + qi0 + l15;
            const bf16_t* qp = Qb + row * DA + head * 64 + 8 * g;
            const bf16x8 q0 = *(const bf16x8*)qp, q1 = *(const bf16x8*)(qp + 32);
            attn_group(lds, key0, q0, q1, qi0 + l15 + WIN - key0, nb == 0 ? WIN : 0, hl, ATT + row * DA + head * 64, lane);
        }
    }
    for (int u = blockIdx.x; u < DBATCH * 4; u += F.G) {
        const int b = u >> 2, kvh = u & 3;
        __syncthreads();
        {
            const int hl = tid >> 7, dist = tid & 127;
            ((LAS float*)(lds + LDS_LUT))[tid] = a.rel_bias[T5_BUCKET[dist] * 16 + kvh * 4 + hl];
            if (tid < 4) ((LAS float*)(lds + LDS_SINK))[tid] = a.sinks[kvh * 4 + tid];
        }
#pragma unroll
        for (int i = 0; i < 4; ++i) {
            const int id = tid + 512 * i, j = id >> 4, c4 = id & 15;
            const size_t off = ((size_t)(b * WIN + j) * 4 + kvh) * 64 + c4 * 4;
            const f32x4 kf = *(const f32x4*)(a.cache_k + off), vf = *(const f32x4*)(a.cache_v + off);
            if (j >= DSEQ) { const size_t oo = ((size_t)(b * WIN + j - DSEQ) * 4 + kvh) * 64 + c4 * 4; *(f32x4*)(a.out + OUT_KS + oo) = kf; *(f32x4*)(a.out + OUT_VS + oo) = vf; }
            u32x2 kw; kw.x = cvt_pk_bf16(kf[0], kf[1]); kw.y = cvt_pk_bf16(kf[2], kf[3]);
            *(LAS u32x2*)(lds + LDS_KIMG + j * KIMG_STRIDE + c4 * 8) = kw;
            const unsigned v01 = cvt_pk_bf16(vf[0], vf[1]), v23 = cvt_pk_bf16(vf[2], vf[3]);
            LAS unsigned char* vt = lds + LDS_VT + (c4 * 4) * VT_STRIDE + j * 2;
            *(LAS bf16_t*)(vt + 0 * VT_STRIDE) = (bf16_t)(v01 & 0xffffu); *(LAS bf16_t*)(vt + 1 * VT_STRIDE) = (bf16_t)(v01 >> 16);
            *(LAS bf16_t*)(vt + 2 * VT_STRIDE) = (bf16_t)(v23 & 0xffffu); *(LAS bf16_t*)(vt + 3 * VT_STRIDE) = (bf16_t)(v23 >> 16);
        }
        if (tid < 256) {
            const int r = WIN + (tid >> 3), c8 = tid & 7;
            u32x4 kv = (u32x4){0u, 0u, 0u, 0u}, vv = (u32x4){0u, 0u, 0u, 0u};
            if (r < WIN + DSEQ) { const size_t off = (size_t)(MP + b * DSEQ + (r - WIN)) * DKV + kvh * 64 + c8 * 8; kv = *(const u32x4*)(Kb + off); vv = *(const u32x4*)(Vb + off); }
            *(LAS u32x4*)(lds + LDS_KIMG + r * KIMG_STRIDE + c8 * 16) = kv;
            LAS unsigned char* vt = lds + LDS_VT + (c8 * 8) * VT_STRIDE + r * 2;
            *(LAS bf16_t*)(vt + 0 * VT_STRIDE) = (bf16_t)(vv.x & 0xffffu); *(LAS bf16_t*)(vt + 1 * VT_STRIDE) = (bf16_t)(vv.x >> 16);
            *(LAS bf16_t*)(vt + 2 * VT_STRIDE) = (bf16_t)(vv.y & 0xffffu); *(LAS bf16_t*)(vt + 3 * VT_STRIDE) = (bf16_t)(vv.y >> 16);
            *(LAS bf16_t*)(vt + 4 * VT_STRIDE) = (bf16_t)(vv.z & 0xffffu); *(LAS bf16_t*)(vt + 5 * VT_STRIDE) = (bf16_t)(vv.z >> 16);
            *(LAS bf16_t*)(vt + 6 * VT_STRIDE) = (bf16_t)(vv.w & 0xffffu); *(LAS bf16_t*)(vt + 7 * VT_STRIDE) = (bf16_t)(vv.w >> 16);
        }
        __syncthreads();
        if (wave < 2) {
            const int t = l15 & 7, hl = 2 * wave + (l15 >> 3), head = kvh * 4 + hl;
            const size_t row = (size_t)MP + b * DSEQ + t;
            const bf16_t* qp = Qb + row * DA + head * 64 + 8 * g;
            const bf16x8 q0 = *(const bf16x8*)qp, q1 = *(const bf16x8*)(qp + 32);
            attn_group(lds, 0, q0, q1, t + WIN, 0, hl, ATT + row * DA + head * 64, lane);
        }
    }
    __syncthreads();
    {
        const bf16_t* U = (const bf16_t*)(ws + WS_U); const bf16_t* Bg = (const bf16_t*)(ws + WS_BG); bf16_t* AC = (bf16_t*)(ws + WS_ACONV);
        for (int id = blockIdx.x * (NWAVES * 64) + tid; id < M * (DC / 8); id += F.G * (NWAVES * 64)) {
            const int row = id >> 7, c = (id & 127) * 8;
            f32x4 u2a, u2b, u1a, u1b, u0a, u0b, ba, bb;
            pg8::unpack8(*(const u32x4*)(U + (size_t)row * DC + c), u0a, u0b);
            pg8::unpack8(*(const u32x4*)(Bg + (size_t)row * DC + c), ba, bb);
            int t; const float* st = nullptr;
            if (row < MP) t = row & (SEQ - 1); else { const int s = row - MP; t = s & 7; st = a.state_conv + (size_t)(s >> 3) * 2 * DC + c; }
            if (t >= 1) pg8::unpack8(*(const u32x4*)(U + (size_t)(row - 1) * DC + c), u1a, u1b);
            else if (st) { u1a = *(const f32x4*)(st + DC); u1b = *(const f32x4*)(st + DC + 4); }
            else { u1a = (f32x4){0.f, 0.f, 0.f, 0.f}; u1b = u1a; }
            if (t >= 2) pg8::unpack8(*(const u32x4*)(U + (size_t)(row - 2) * DC + c), u2a, u2b);
            else if (st) { const float* p = st + (t == 1 ? DC : 0); u2a = *(const f32x4*)p; u2b = *(const f32x4*)(p + 4); }
            else { u2a = (f32x4){0.f, 0.f, 0.f, 0.f}; u2b = u2a; }
            const f32x4 w0a = *(const f32x4*)(a.w_conv + c), w0b = *(const f32x4*)(a.w_conv + c + 4), w1a = *(const f32x4*)(a.w_conv + DC + c), w1b = *(const f32x4*)(a.w_conv + DC + c + 4),
                        w2a = *(const f32x4*)(a.w_conv + 2 * DC + c), w2b = *(const f32x4*)(a.w_conv + 2 * DC + c + 4);
            const f32x4 oa = ba * (w0a * u2a + w1a * u1a + w2a * u0a), ob = bb * (w0b * u2b + w1b * u1b + w2b * u0b);
            *(u32x4*)(AC + (size_t)row * DC + c) = pg8::pack8(oa, ob);
        }
    }
}

__device__ __forceinline__ void norm_tail(const Frame& F, const Args& a, unsigned* ctl, volatile LAS unsigned* slot) {
    for (;;) {
        __syncthreads();
        if (F.tid == 0) *slot = __hip_atomic_fetch_add(ctl + CW_TICKET, 1u, __ATOMIC_RELAXED, __HIP_MEMORY_SCOPE_AGENT);
        __syncthreads();
        const unsigned t = (unsigned)__builtin_amdgcn_readfirstlane((int)*slot);
        if (t >= (unsigned)(M / 32)) break;
        const int pm = (int)(t >> 3), sb = (int)(t & 7);
        if (F.wave == 0) pg8::stream_poll_block(ctl + CW_CNT + (pg8::CNT_DN * 36 + pm) * 64, 128u, ctl + CW_TMO);
        __syncthreads();
#pragma unroll 1
        for (int i = 0; i < 4; ++i) {
            const int m = pm * 256 + sb * 32 + F.wave * 4 + i;
            f32x4* xr = (f32x4*)(a.out + OUT_Y + (size_t)m * D) + F.lane; const f32x4* gr = (const f32x4*)a.g_final + F.lane;
            const u32x2* pr = (const u32x2*)((const bf16_t*)(a.ws + WS_SG1) + (size_t)m * D) + F.lane;
            const u32x2* hr = (const u32x2*)((const bf16_t*)(a.ws + WS_SG2) + (size_t)m * D) + F.lane;
            f32x4 v[8]; float s = 0.f;
#pragma unroll
            for (int j = 0; j < 8; ++j) { const u32x2 pw = pr[64 * j], hw = hr[64 * j];
                v[j] = (f32x4){bf_lo(hw.x), bf_hi(hw.x), bf_lo(hw.y), bf_hi(hw.y)} + (f32x4){bf_lo(pw.x), bf_hi(pw.x), bf_lo(pw.y), bf_hi(pw.y)}; s += (v[j][0] * v[j][0] + v[j][1] * v[j][1]) + (v[j][2] * v[j][2] + v[j][3] * v[j][3]); }
            const float rstd = __builtin_amdgcn_rsqf(wave_sum(s) * (1.0f / D) + EPS);
#pragma unroll
            for (int j = 0; j < 8; ++j) xr[64 * j] = v[j] * rstd * gr[64 * j];
        }
    }
}

constexpr int N_PHASES = 4;
__global__ void __launch_bounds__(NWAVES * 64, 2) fwd_kernel(Args args) {
    extern __shared__ __attribute__((aligned(16))) unsigned char lds_raw[];
    Frame F;
    F.lds = (LAS unsigned char*)lds_raw;
    F.tid = threadIdx.x; F.lane = F.tid & 63; F.wave = __builtin_amdgcn_readfirstlane(F.tid >> 6);
    F.G = gridDim.x; { const int bx = blockIdx.x; F.vcu = (F.G % 8 == 0) ? (bx % 8) * (F.G / 8) + bx / 8 : bx; }
    unsigned char* ws = args.ws;
    unsigned* ctl = (unsigned*)(ws + WS_CTL);
    volatile LAS unsigned* MISC = (volatile LAS unsigned*)(F.lds + MISC_OFF);
    for (int u = F.tid; u < (LDS_BYTES - LDSCTL_OFF) / 4; u += NWAVES * 64) ((LAS unsigned*)(F.lds + LDSCTL_OFF))[u] = 0u;
    __syncthreads();
    XcdBarrier bar; bar.bar = ctl + CW_BAR; bar.x = 0; bar.st = nullptr;
    if (MK_N_LAUNCHES == 1) bar = xcd_barrier_post(ctl + CW_BAR, MISC + 8);
    const int lo = args.ph_lo, hi = args.ph_hi;
#define IN(k) (lo <= (k) && (k) < hi)
#define SEAM(k) do { if (IN(k) && IN((k) + 1)) xcd_barrier(bar); } while (0)
    float* rowss = (float*)(ctl + CW_ROWSS);

#ifndef REP0
#define REP0 1
#endif
#ifndef REP2
#define REP2 1
#endif
    if (IN(0)) { for (int rep = 0; rep < REP0; ++rep) { p0_prologue(F, args); SEAM(0); } }
    if (IN(1)) {
        pg8::SchedG S; S.o.init(M / 256, NIN / 256, F.G, (int)blockIdx.x); S.A = (const char*)(ws + WS_XN); S.B = (const char*)(ws + WS_WIN); S.tstep = (size_t)256 * D * 2;
        pg8::EpiIn E{(bf16_t*)(ws + WS_BG), (bf16_t*)(ws + WS_U), (bf16_t*)(ws + WS_Q), (bf16_t*)(ws + WS_K), (bf16_t*)(ws + WS_V), (bf16_t*)(ws + WS_SG1), (bf16_t*)(ws + WS_SG2), args.out};
        pg8::gemm_phase(F.lds, D, S, E);
        SEAM(1);
    }
    if (IN(2)) { for (int rep = 0; rep < REP2; ++rep) { p2_attention_conv(F, args); SEAM(2); } }
    if (IN(3)) {
        pg8::StreamSched S; S.x = F.vcu >> 5; S.r = F.vcu & 31;
        S.c.ACONV = (const char*)(ws + WS_ACONV); S.c.ATT = (const char*)(ws + WS_ATT); S.c.WC = (const char*)(ws + WS_WC); S.c.WA = (const char*)(ws + WS_WA);
        S.c.MERGED = (const char*)(ws + WS_SG1); S.c.WO = (const char*)(ws + WS_WO); S.c.HB = (const char*)(ws + WS_SG2); S.c.WGU = (const char*)(ws + WS_WGU);
        S.c.ACT1 = (const char*)(ws + WS_ACT1); S.c.ACT2 = (const char*)(ws + WS_ACT2); S.c.WD = (const char*)(ws + WS_WD); S.c.cnt = ctl + CW_CNT;
        pg8::EpiStream E{(bf16_t*)(ws + WS_SG1), (bf16_t*)(ws + WS_SG2), args.x_prompt, args.x_sample, args.out + OUT_Y, rowss, (bf16_t*)(ws + WS_ACT1), (bf16_t*)(ws + WS_ACT2)};
        pg8::gemm_stream(F.lds, MISC + 16, S, E, ctl + CW_TMO);
        norm_tail(F, args, ctl, MISC + 24);
    }

#undef IN
#undef SEAM
}

extern "C" void kernel_launch(void* const* d_in, const int* in_sizes, int n_in, void* d_out, int out_size, void* d_ws, size_t ws_size, hipStream_t stream) {
    static int grid = 0;
    if (grid == 0) {
        if (n_in != 18 || (size_t)out_size != OUT_END || ws_size < WS_END) { fprintf(stderr, "kernel_launch: unexpected shapes: n_in %d out %d ws %zu (need %zu)\n", n_in, out_size, ws_size, (size_t)WS_END); grid = -1; return; }
        int dev = 0, cus = 0, per_cu = 0;
        if (hipGetDevice(&dev) != hipSuccess || hipDeviceGetAttribute(&cus, hipDeviceAttributeMultiprocessorCount, dev) != hipSuccess) { grid = -1; return; }
        if (hipFuncSetAttribute((const void*)fwd_kernel, hipFuncAttributeMaxDynamicSharedMemorySize, LDS_BYTES) != hipSuccess) { fprintf(stderr, "kernel_launch: hipFuncSetAttribute failed\n"); grid = -1; return; }
        if (hipOccupancyMaxActiveBlocksPerMultiprocessor(&per_cu, (const void*)fwd_kernel, NWAVES * 64, LDS_BYTES) != hipSuccess || per_cu < 1) { fprintf(stderr, "kernel_launch: occupancy query says %d blocks per CU\n", per_cu); per_cu = 1; }
        (void)hipGetLastError();
        grid = cus;
    }
    if (grid < 0) return;
    (void)hipMemsetAsync((char*)d_ws + WS_CTL, 0, CTL_ZERO_BYTES, stream);
    Args a{};
    a.x_prompt = (const float*)d_in[0]; a.x_sample = (const float*)d_in[1]; a.cache_k = (const float*)d_in[2]; a.cache_v = (const float*)d_in[3]; a.state_conv = (const float*)d_in[4];
    a.rel_bias = (const float*)d_in[5]; a.w_in = (const float*)d_in[6]; a.w_conv = (const float*)d_in[7]; a.w_conv_out = (const float*)d_in[8]; a.sinks = (const float*)d_in[9];
    a.w_attn_out = (const float*)d_in[10]; a.w_o = (const float*)d_in[11]; a.g_mix = (const float*)d_in[12]; a.g_ffn = (const float*)d_in[13]; a.w_gate = (const float*)d_in[14];
    a.w_up = (const float*)d_in[15]; a.w_down = (const float*)d_in[16]; a.g_final = (const float*)d_in[17];
    a.out = (float*)d_out; a.ws = (unsigned char*)d_ws;
    if (MK_N_LAUNCHES == 1) {
        a.ph_lo = 0; a.ph_hi = N_PHASES;
        void* kargs[] = {&a};
        hipError_t e = hipLaunchCooperativeKernel((const void*)fwd_kernel, dim3(grid), dim3(NWAVES * 64), kargs, LDS_BYTES, stream);
        if (e != hipSuccess) fprintf(stderr, "kernel_launch: cooperative launch failed: %s (grid %d)\n", hipGetErrorString(e), grid);
    } else {
        for (int p = 0; p < N_PHASES; ++p) {
            a.ph_lo = p; a.ph_hi = p + 1;
            hipLaunchKernelGGL(fwd_kernel, dim3(grid), dim3(NWAVES * 64), LDS_BYTES, stream, a);
        }
    }
}
```
